# Optimizing an MI355X kernel written in HIP

```python
import jax, jax.numpy as jnp
from jax import lax
import numpy as np

D_MODEL = 4096
BATCH = 2
SEQ = 4096
DEPTH = 2

N_MIXERS = 2
N_ATTN_LAYERS = (DEPTH + 1) // 2
N_RNN_LAYERS = DEPTH // 2
DA_HEAD_DIM = 128
DA_HEADS = D_MODEL // (2 * DA_HEAD_DIM)
ROT_DIM = DA_HEAD_DIM // 4
ROPE_THETA = 500000.0
Q_BLOCK = 128
LAMBDA_STD = 0.1
LRU_WIDTH = D_MODEL
LRU_BLOCKS = 16
LRU_BLOCK_W = LRU_WIDTH // LRU_BLOCKS
CONV_WIDTH = 4
CONV_LEFT = 2
LRU_C = 8.0
MEM_TOKENS = 256
X_HEADS = 4
X_HEAD_DIM = 128
X_WIDTH = X_HEADS * X_HEAD_DIM
D_FF = 4 * D_MODEL
EPS = 1e-6

kernel_name = 'hybrid_diffattn_rglru_encoder'


def rmsnorm(x, g):
    xf = x.astype(jnp.float32)
    y = xf * lax.rsqrt(jnp.mean(xf * xf, axis=-1, keepdims=True) + EPS)
    return (y * g.astype(jnp.float32)).astype(x.dtype)


def lambda_init(layer_idx):
    return 0.8 - 0.6 * float(np.exp(-0.3 * layer_idx))


def apply_partial_rope(t, cos, sin):
    half = ROT_DIM // 2
    tf = t.astype(jnp.float32)
    r1, r2, rest = tf[..., :half], tf[..., half:ROT_DIM], tf[..., ROT_DIM:]
    out = jnp.concatenate([r1 * cos - r2 * sin, r2 * cos + r1 * sin, rest], axis=-1)
    return out.astype(t.dtype)


def diff_attention(xn, w_qkv, lq1, lk1, lq2, lk2, subln_g, w_o, cos, sin, lam_init):
    B, S, _ = xn.shape
    q, k, v = jnp.split(xn @ w_qkv, 3, axis=-1)
    q = apply_partial_rope(q.reshape(B, S, DA_HEADS, 2, DA_HEAD_DIM), cos, sin) * (DA_HEAD_DIM ** -0.5)
    k = apply_partial_rope(k.reshape(B, S, DA_HEADS, 2, DA_HEAD_DIM), cos, sin)
    v = v.reshape(B, S, DA_HEADS, 2 * DA_HEAD_DIM)
    f32 = jnp.float32
    lam = (jnp.exp(jnp.sum(lq1.astype(f32) * lk1.astype(f32)))
           - jnp.exp(jnp.sum(lq2.astype(f32) * lk2.astype(f32))) + lam_init)
    nb = S // Q_BLOCK
    qb = q.reshape(B, nb, Q_BLOCK, DA_HEADS, 2, DA_HEAD_DIM).transpose(1, 0, 3, 4, 2, 5)
    kt = k.transpose(0, 2, 3, 1, 4)
    vt = v.transpose(0, 2, 1, 3)

    def block(qblk):
        s = jnp.einsum('bhmqd,bhmkd->bhmqk', qblk, kt).astype(f32)
        p = jax.nn.softmax(s, axis=-1)
        w = p[:, :, 0] - lam * p[:, :, 1]
        return jnp.einsum('bhqk,bhkv->bhqv', w.astype(vt.dtype), vt)

    o = lax.map(block, qb)
    o = o.transpose(1, 0, 3, 2, 4).reshape(B, S, DA_HEADS, 2 * DA_HEAD_DIM)
    o = rmsnorm(o, subln_g) * (1.0 - lam_init)
    return o.reshape(B, S, DA_HEADS * 2 * DA_HEAD_DIM) @ w_o


def _linear_combine(c1, c2):
    a1, b1 = c1
    a2, b2 = c2
    return a1 * a2, a2 * b1 + b2


def _block_diag(u, w, b):
    B, S, _ = u.shape
    ub = u.reshape(B, S, LRU_BLOCKS, LRU_BLOCK_W)
    return (jnp.einsum('bsnc,ncd->bsnd', ub, w) + b).reshape(B, S, LRU_WIDTH)


def rglru_scan(u, w_a, b_a, w_i, b_i, lam, reverse):
    f32 = jnp.float32
    r = jax.nn.sigmoid(_block_diag(u, w_a, b_a).astype(f32))
    ig = jax.nn.sigmoid(_block_diag(u, w_i, b_i).astype(f32))
    log_a = -LRU_C * r * jax.nn.softplus(-lam.astype(f32))
    a = jnp.exp(log_a)
    inp = jnp.sqrt(-jnp.expm1(2.0 * log_a)) * (ig * u.astype(f32))
    _, h = lax.associative_scan(_linear_combine, (a, inp), axis=1, reverse=reverse)
    return h.astype(u.dtype)


def rglru_block(xn, w_in, conv_w, conv_b, wa_f, ba_f, wi_f, bi_f, lam_f,
                wa_b, ba_b, wi_b, bi_b, lam_b, w_out):
    S = xn.shape[1]
    u, gate = jnp.split(xn @ w_in, 2, axis=-1)
    up = jnp.pad(u, ((0, 0), (CONV_LEFT, CONV_WIDTH - 1 - CONV_LEFT), (0, 0)))
    uc = sum((up[:, t:t + S] * conv_w[t] for t in range(CONV_WIDTH)), conv_b)
    h = (rglru_scan(uc, wa_f, ba_f, wi_f, bi_f, lam_f, False)
         + rglru_scan(uc, wa_b, ba_b, wi_b, bi_b, lam_b, True))
    return (h * jax.nn.gelu(gate, approximate=True)) @ w_out


def memory_xattn(xn, mem, mem_g, w_q, w_kv, w_o):
    B, S, _ = xn.shape
    q = (xn @ w_q).reshape(B, S, X_HEADS, X_HEAD_DIM) * (X_HEAD_DIM ** -0.5)
    k, v = jnp.split(rmsnorm(mem, mem_g) @ w_kv, 2, axis=-1)
    k = k.reshape(B, -1, X_HEADS, X_HEAD_DIM)
    v = v.reshape(B, -1, X_HEADS, X_HEAD_DIM)
    p = jax.nn.softmax(jnp.einsum('bqhd,bkhd->bhqk', q, k).astype(jnp.float32), axis=-1)
    o = jnp.einsum('bhqk,bkhd->bqhd', p.astype(v.dtype), v).reshape(B, S, X_WIDTH)
    return o @ w_o


def sq_relu_mlp(xn, w1, w2):
    return jnp.square(jax.nn.relu(xn @ w1)) @ w2


def setup_inputs(seed: int = 0) -> dict:
    key = jax.random.key(seed)
    ks = iter(jax.random.split(key, 64))
    f32 = jnp.float32

    def nrm(shape, scale):
        return jax.random.normal(next(ks), shape, f32) * scale

    def gain(shape):
        return 1.0 + nrm(shape, 0.02)

    def lru_lambda(n):
        a_c = jax.random.uniform(next(ks), (n, LRU_WIDTH), f32, 0.9, 0.999)
        s = a_c ** (1.0 / LRU_C)
        return jnp.log(s) - jnp.log1p(-s)

    NA, NR = N_ATTN_LAYERS, N_RNN_LAYERS
    x = jax.random.normal(next(ks), (BATCH, SEQ, D_MODEL), f32)
    mem = jax.random.normal(next(ks), (BATCH, MEM_TOKENS, D_MODEL), f32)
    offsets = jax.random.randint(next(ks), (BATCH, 1), 0, 1024, jnp.int32)
    positions = jnp.arange(SEQ, dtype=jnp.int32)[None, :] + offsets
    d = D_MODEL ** -0.5
    return {
        'x': x, 'mem': mem, 'positions': positions,
        'attn_norm_g': gain((NA, D_MODEL)),
        'attn_w_qkv': nrm((NA, D_MODEL, 3 * D_MODEL), d),
        'attn_lambda_q1': nrm((NA, DA_HEAD_DIM), LAMBDA_STD),
        'attn_lambda_k1': nrm((NA, DA_HEAD_DIM), LAMBDA_STD),
        'attn_lambda_q2': nrm((NA, DA_HEAD_DIM), LAMBDA_STD),
        'attn_lambda_k2': nrm((NA, DA_HEAD_DIM), LAMBDA_STD),
        'attn_subln_g': gain((NA, 2 * DA_HEAD_DIM)),
        'attn_w_o': nrm((NA, D_MODEL, D_MODEL), d),
        'rnn_norm_g': gain((NR, D_MODEL)),
        'rnn_w_in': nrm((NR, D_MODEL, 2 * LRU_WIDTH), d),
        'rnn_conv_w': nrm((NR, CONV_WIDTH, LRU_WIDTH), CONV_WIDTH ** -0.5),
        'rnn_conv_b': nrm((NR, LRU_WIDTH), 0.01),
        'rnn_wa_f': nrm((NR, LRU_BLOCKS, LRU_BLOCK_W, LRU_BLOCK_W), LRU_BLOCK_W ** -0.5),
        'rnn_ba_f': nrm((NR, LRU_BLOCKS, LRU_BLOCK_W), 0.01),
        'rnn_wi_f': nrm((NR, LRU_BLOCKS, LRU_BLOCK_W, LRU_BLOCK_W), LRU_BLOCK_W ** -0.5),
        'rnn_bi_f': nrm((NR, LRU_BLOCKS, LRU_BLOCK_W), 0.01),
        'rnn_lam_f': lru_lambda(NR),
        'rnn_wa_b': nrm((NR, LRU_BLOCKS, LRU_BLOCK_W, LRU_BLOCK_W), LRU_BLOCK_W ** -0.5),
        'rnn_ba_b': nrm((NR, LRU_BLOCKS, LRU_BLOCK_W), 0.01),
        'rnn_wi_b': nrm((NR, LRU_BLOCKS, LRU_BLOCK_W, LRU_BLOCK_W), LRU_BLOCK_W ** -0.5),
        'rnn_bi_b': nrm((NR, LRU_BLOCKS, LRU_BLOCK_W), 0.01),
        'rnn_lam_b': lru_lambda(NR),
        'rnn_w_out': nrm((NR, LRU_WIDTH, D_MODEL), LRU_WIDTH ** -0.5),
        'xattn_norm_g': gain((DEPTH, D_MODEL)),
        'xattn_mem_g': gain((DEPTH, D_MODEL)),
        'xattn_w_q': nrm((DEPTH, D_MODEL, X_WIDTH), d),
        'xattn_w_kv': nrm((DEPTH, D_MODEL, 2 * X_WIDTH), d),
        'xattn_w_o': nrm((DEPTH, X_WIDTH, D_MODEL), X_WIDTH ** -0.5),
        'mlp_norm_g': gain((DEPTH, D_MODEL)),
        'mlp_w1': nrm((DEPTH, D_MODEL, D_FF), d),
        'mlp_w2': nrm((DEPTH, D_FF, D_MODEL), D_FF ** -0.5),
        'final_g': gain((D_MODEL,)),
    }


def reference(x, mem, positions,
              attn_norm_g, attn_w_qkv, attn_lambda_q1, attn_lambda_k1, attn_lambda_q2,
              attn_lambda_k2, attn_subln_g, attn_w_o,
              rnn_norm_g, rnn_w_in, rnn_conv_w, rnn_conv_b,
              rnn_wa_f, rnn_ba_f, rnn_wi_f, rnn_bi_f, rnn_lam_f,
              rnn_wa_b, rnn_ba_b, rnn_wi_b, rnn_bi_b, rnn_lam_b, rnn_w_out,
              xattn_norm_g, xattn_mem_g, xattn_w_q, xattn_w_kv, xattn_w_o,
              mlp_norm_g, mlp_w1, mlp_w2, final_g):
    inv_freq = ROPE_THETA ** (-jnp.arange(0, ROT_DIM, 2, dtype=jnp.float32) / ROT_DIM)
    ang = positions.astype(jnp.float32)[..., None] * inv_freq
    cos = jnp.cos(ang)[:, :, None, None, :]
    sin = jnp.sin(ang)[:, :, None, None, :]
    h = x
    for i in range(DEPTH):
        j = i // N_MIXERS
        if i % N_MIXERS == 0:
            h = h + diff_attention(rmsnorm(h, attn_norm_g[j]), attn_w_qkv[j],
                                   attn_lambda_q1[j], attn_lambda_k1[j],
                                   attn_lambda_q2[j], attn_lambda_k2[j],
                                   attn_subln_g[j], attn_w_o[j], cos, sin, lambda_init(i))
        else:
            h = h + rglru_block(rmsnorm(h, rnn_norm_g[j]), rnn_w_in[j], rnn_conv_w[j], rnn_conv_b[j],
                                rnn_wa_f[j], rnn_ba_f[j], rnn_wi_f[j], rnn_bi_f[j], rnn_lam_f[j],
                                rnn_wa_b[j], rnn_ba_b[j], rnn_wi_b[j], rnn_bi_b[j], rnn_lam_b[j],
                                rnn_w_out[j])
        h = h + memory_xattn(rmsnorm(h, xattn_norm_g[i]), mem, xattn_mem_g[i],
                             xattn_w_q[i], xattn_w_kv[i], xattn_w_o[i])
        h = h + sq_relu_mlp(rmsnorm(h, mlp_norm_g[i]), mlp_w1[i], mlp_w2[i])
    return rmsnorm(h, final_g)
```

```cpp
#include <hip/hip_runtime.h>
#include <cstdio>
#include <cstdint>
namespace pg8 {
__device__ __forceinline__ int lane_now() { int l; asm volatile("v_mbcnt_lo_u32_b32 %0, -1, 0\n\tv_mbcnt_hi_u32_b32 %0, -1, %0" : "=v"(l)); return l; }
#define PG8_LAS __attribute__((address_space(3)))
typedef unsigned short bf16_t;
typedef short bf16x8 __attribute__((ext_vector_type(8)));
typedef float f32x4 __attribute__((ext_vector_type(4)));
typedef float f32x2 __attribute__((ext_vector_type(2)));
typedef unsigned u32x4 __attribute__((ext_vector_type(4)));
typedef unsigned u32x2 __attribute__((ext_vector_type(2)));
constexpr int BM = 256, BK = 64, HALF = 128, HTB = HALF * BK * 2  , STAGE_BYTES = 8 * HTB, NXCD = 8, WGM = 8;

__host__ __device__ __forceinline__ int lds_byte(int r, int c) { const int st = (r >> 4) * 2 + (c >> 5), rr = r & 15, cc = c & 31, ob = rr * 64 + cc * 2; return st * 1024 + (ob ^ (((ob >> 9) & 1) << 5)); }
__host__ __device__ __forceinline__ void stage_rc(int b, int& R, int& C) { const int st = b / 1024, sb = b % 1024, swz = sb ^ (((sb >> 9) & 1) << 5); R = (st >> 1) * 16 + swz / 64; C = (st & 1) * 32 + (swz % 64) / 2; }
__host__ __device__ __forceinline__ int perm32(int rho) { const int n = rho >> 4, i = rho & 15; return 8 * (i >> 2) + 4 * n + (i & 3); }

struct Unit { const char* A; const char* B; int pm, pn, nt, job, aux; };

struct StaticOrder {
    int nM, nN, nwg, G, c;
    __device__ void init(int M, int N, int G_, int c_) { nM = M / BM; nN = N / BM; nwg = nM * nN; G = G_; c = c_; }
    __device__ bool next(int i, int& pm, int& pn) const {
        const long L = (long)i * G + c; if (L >= nwg) return false;
        int wgid = (int)L; { const int q = nwg / NXCD, r = nwg % NXCD, xcd = wgid % NXCD, off = wgid / NXCD; wgid = (xcd < r ? xcd * (q + 1) : r * (q + 1) + (xcd - r) * q) + off; }
        const int nig = WGM * nN, gid = wgid / nig, fm = gid * WGM, gsz = (nM - fm) < WGM ? (nM - fm) : WGM;
        pm = fm + ((wgid % nig) % gsz); pn = (wgid % nig) / gsz; return true;
    }
};
struct SchedPlain {
    const char* A; const char* B; unsigned lda, ldb; int nt; StaticOrder so;
    __device__ __forceinline__ bool next(int i, Unit& u) const { int pm, pn; if (!so.next(i, pm, pn)) return false;
        u.pm = pm; u.pn = pn; u.A = A + (size_t)pm * BM * lda; u.B = B + (size_t)pn * BM * ldb; u.nt = nt; u.job = 0; u.aux = 0; return true; }
};

__device__ __forceinline__ unsigned cvt_pk_bf16(float lo, float hi) { unsigned r; asm volatile("v_cvt_pk_bf16_f32 %0, %1, %2" : "=v"(r) : "v"(lo), "v"(hi)); return r; }
__device__ __forceinline__ float bf_lo(unsigned w) { return __uint_as_float(w << 16); }
__device__ __forceinline__ float bf_hi(unsigned w) { return __uint_as_float(w & 0xffff0000u); }


#define PG8_OPAQUE(p) asm volatile("" : "+s"(p))
#define PG8_PIN(v) asm volatile("" : "+v"(v))
template <class T> __device__ __forceinline__ T ldg(const void* base, unsigned boff) { return *(const __attribute__((address_space(1))) T*)((const __attribute__((address_space(1))) char*)base + boff); }
template <class T> __device__ __forceinline__ void stg(void* base, unsigned boff, T v) { *(__attribute__((address_space(1))) T*)((__attribute__((address_space(1))) char*)base + boff) = v; }

template <int ACT, int LDC> struct EpiBf16 {
    static constexpr bool PERM = true;
    bf16_t* O; const unsigned long long* rowss;
    __device__ __forceinline__ void operator()(const f32x4 (&acc)[2][2][4][2], const Unit& u, int wr, int wc, int fr, int fq) const {
        char* ob = (char*)O + ((size_t)u.pm * BM * LDC + (size_t)u.pn * BM) * 2;
        PG8_OPAQUE(ob);
        unsigned l0 = ((unsigned)(wr * 64 + fr) * LDC + (unsigned)(wc * 32 + 8 * fq)) * 2u; PG8_PIN(l0);
        float rs[2][4];
        if (rowss) { const char* rsb = (const char*)rowss + (size_t)u.pm * BM * 8; PG8_OPAQUE(rsb); unsigned r0 = (unsigned)(wr * 64 + fr) * 8u; PG8_PIN(r0);
#pragma unroll
            for (int ai = 0; ai < 2; ++ai)
#pragma unroll
                for (int m = 0; m < 4; ++m) rs[ai][m] = __builtin_amdgcn_rsqf((float)ldg<unsigned long long>(rsb, r0 + (unsigned)((ai * HALF + m * 16) * 8)) * (1.f / (4096.f * 16777216.f)) + 1e-6f);
        } else {
#pragma unroll
            for (int ai = 0; ai < 2; ++ai)
#pragma unroll
                for (int m = 0; m < 4; ++m) rs[ai][m] = 1.f; }
#pragma unroll
        for (int ai = 0; ai < 2; ++ai)
#pragma unroll
            for (int m = 0; m < 4; ++m)
#pragma unroll
                for (int bj = 0; bj < 2; ++bj) { f32x4 v0 = acc[ai][bj][m][0] * rs[ai][m], v1 = acc[ai][bj][m][1] * rs[ai][m];
                    if (ACT == 2) {
#pragma unroll
                        for (int j = 0; j < 4; ++j) { const float a = fmaxf(v0[j], 0.f), b = fmaxf(v1[j], 0.f); v0[j] = a * a; v1[j] = b * b; } }
                    u32x4 w; w.x = cvt_pk_bf16(v0[0], v0[1]); w.y = cvt_pk_bf16(v0[2], v0[3]); w.z = cvt_pk_bf16(v1[0], v1[1]); w.w = cvt_pk_bf16(v1[2], v1[3]);
                    stg<u32x4>(ob, l0 + (unsigned)((ai * HALF + m * 16) * LDC + bj * HALF) * 2u, w); }
    }
};

struct EpiQKV {
    static constexpr bool PERM = true;
    bf16_t* Q; size_t stride; const float* ct; const float* st;
    __device__ __forceinline__ void operator()(const f32x4 (&acc)[2][2][4][2], const Unit& u, int wr, int wc, int fr, int fq) const {
        const int t = u.pn >> 4, hd = u.pn & 15, bb = u.pm >> 4, s0 = (u.pm & 15) * BM;
        char* ob = (char*)(Q + (size_t)t * stride) + (((size_t)(bb * 16 + hd) * 2) * 4096 + (size_t)s0) * 256;
        unsigned l0 = ((unsigned)(wr * 64 + fr) * 128u + (unsigned)(wc * 32 + 8 * fq)) * 2u; PG8_PIN(l0);
        const char* ctb = (const char*)ct + (size_t)u.pm * BM * 64; const char* stb = (const char*)st + (size_t)u.pm * BM * 64;
        PG8_OPAQUE(ob); PG8_OPAQUE(ctb); PG8_OPAQUE(stb);
        unsigned t0 = (unsigned)(wr * 64 + fr) * 64u + (unsigned)(8 * (fq & 1)) * 4u; PG8_PIN(t0);
        const bool rot = (t < 2) && (wc == 0);
#pragma unroll
        for (int g = 0; g < 4; ++g) {
            const int ai = g >> 1, mb = 2 * (g & 1);
            f32x4 c0[2], c1[2], s0[2], s1[2];
            if (rot) {
#pragma unroll
                for (int m = 0; m < 2; ++m) { const unsigned to = t0 + (unsigned)(ai * HALF + (mb + m) * 16) * 64u;
                    c0[m] = ldg<f32x4>(ctb, to); c1[m] = ldg<f32x4>(ctb, to + 16); s0[m] = ldg<f32x4>(stb, to); s1[m] = ldg<f32x4>(stb, to + 16);
                    if (fq < 2) { s0[m] = -s0[m]; s1[m] = -s1[m]; } }
                asm volatile("" ::: "memory"); }
#pragma unroll
            for (int m = 0; m < 2; ++m) {
#pragma unroll
                for (int bj = 0; bj < 2; ++bj) { f32x4 v0 = acc[ai][bj][mb + m][0], v1 = acc[ai][bj][mb + m][1];
                    if (rot) { f32x4 y0, y1;
#pragma unroll
                        for (int j = 0; j < 4; ++j) {
                            const auto ra = __builtin_amdgcn_permlane32_swap(__float_as_uint(v0[j]), __float_as_uint(v0[j]), false, false), rb = __builtin_amdgcn_permlane32_swap(__float_as_uint(v1[j]), __float_as_uint(v1[j]), false, false);
                            y0[j] = __uint_as_float(fq < 2 ? ra[1] : ra[0]); y1[j] = __uint_as_float(fq < 2 ? rb[1] : rb[0]); }
                        v0 = v0 * c0[m] + y0 * s0[m]; v1 = v1 * c1[m] + y1 * s1[m]; }
                    u32x4 w; w.x = cvt_pk_bf16(v0[0], v0[1]); w.y = cvt_pk_bf16(v0[2], v0[3]); w.z = cvt_pk_bf16(v1[0], v1[1]); w.w = cvt_pk_bf16(v1[2], v1[3]);
                    stg<u32x4>(ob, l0 + (unsigned)((ai * HALF + (mb + m) * 16) * 128 + bj * (4096 * 128)) * 2u, w); } }
            asm volatile("" ::: "memory"); }
    }
};

template <int LDC, bool BASE32> struct EpiRes {
    static constexpr bool PERM = true;
    const void* base; bf16_t* out; unsigned long long* rowss;
    __device__ __forceinline__ void operator()(const f32x4 (&acc)[2][2][4][2], const Unit& u, int wr, int wc, int fr, int fq) const {
        const size_t ue = (size_t)u.pm * BM * LDC + (size_t)u.pn * BM;
        const char* bb = (const char*)base + ue * (BASE32 ? 4 : 2); char* ob = (char*)out + ue * 2; char* rsb = (char*)rowss + (size_t)u.pm * BM * 8;
        PG8_OPAQUE(bb); PG8_OPAQUE(ob); PG8_OPAQUE(rsb);
        const bool stats = rowss != nullptr;
        unsigned l0 = (unsigned)(wr * 64 + fr) * LDC + (unsigned)(wc * 32 + 8 * fq); PG8_PIN(l0);
        unsigned r0 = (unsigned)(wr * 64 + fr) * 8u; PG8_PIN(r0);
#pragma unroll
        for (int ai = 0; ai < 2; ++ai) {
            f32x4 b[4][2][2];
#pragma unroll
            for (int m = 0; m < 4; ++m)
#pragma unroll
                for (int bj = 0; bj < 2; ++bj) { const unsigned e = l0 + (unsigned)((ai * HALF + m * 16) * LDC + bj * HALF);
                    if (BASE32) { b[m][bj][0] = ldg<f32x4>(bb, e * 4u); b[m][bj][1] = ldg<f32x4>(bb, e * 4u + 16u); }
                    else { const u32x4 w = ldg<u32x4>(bb, e * 2u); b[m][bj][0] = (f32x4){bf_lo(w.x), bf_hi(w.x), bf_lo(w.y), bf_hi(w.y)}; b[m][bj][1] = (f32x4){bf_lo(w.z), bf_hi(w.z), bf_lo(w.w), bf_hi(w.w)}; } }
            asm volatile("" ::: "memory");
#pragma unroll
            for (int m = 0; m < 4; ++m) { float ss = 0.f;
#pragma unroll
                for (int bj = 0; bj < 2; ++bj) { const unsigned e = l0 + (unsigned)((ai * HALF + m * 16) * LDC + bj * HALF);
                    const f32x4 v0 = b[m][bj][0] + acc[ai][bj][m][0], v1 = b[m][bj][1] + acc[ai][bj][m][1];
                    u32x4 w; w.x = cvt_pk_bf16(v0[0], v0[1]); w.y = cvt_pk_bf16(v0[2], v0[3]); w.z = cvt_pk_bf16(v1[0], v1[1]); w.w = cvt_pk_bf16(v1[2], v1[3]);
                    stg<u32x4>(ob, e * 2u, w);
                    ss += ((v0[0] * v0[0] + v0[1] * v0[1]) + (v0[2] * v0[2] + v0[3] * v0[3])) + ((v1[0] * v1[0] + v1[1] * v1[1]) + (v1[2] * v1[2] + v1[3] * v1[3])); }
                if (stats) {
                    { const auto r = __builtin_amdgcn_permlane16_swap(__float_as_uint(ss), __float_as_uint(ss), false, false); ss = __uint_as_float(r[0]) + __uint_as_float(r[1]); }
                    { const auto r = __builtin_amdgcn_permlane32_swap(__float_as_uint(ss), __float_as_uint(ss), false, false); ss = __uint_as_float(r[0]) + __uint_as_float(r[1]); }
                    if (fq == 0) (void)__hip_atomic_fetch_add((unsigned long long*)(rsb + r0 + (unsigned)((ai * HALF + m * 16) * 8)), (unsigned long long)(ss * 16777216.f), __ATOMIC_RELAXED, __HIP_MEMORY_SCOPE_AGENT); } }
            asm volatile("" ::: "memory");
        }
    }
};

struct EpiX1 {
    static constexpr bool PERM = false;
    float* slab; bf16_t* kv0; bf16_t* kv1; const unsigned long long* rowss;
    __device__ __forceinline__ void operator()(const f32x4 (&acc)[2][2][4][2], const Unit& u, int wr, int wc, int fr, int fq) const {
        if (u.job == 0) { char* ob = (char*)slab + ((size_t)u.aux * ((size_t)8192 * 512) + (size_t)u.pm * BM * 512 + (size_t)u.pn * BM) * 4;
            PG8_OPAQUE(ob);
            unsigned l0 = ((unsigned)(wr * 64 + fr) * 512u + (unsigned)(wc * 32 + 4 * fq)) * 4u; PG8_PIN(l0);
            const char* rsb = (const char*)rowss + (size_t)u.pm * BM * 8; PG8_OPAQUE(rsb); unsigned r0 = (unsigned)(wr * 64 + fr) * 8u; PG8_PIN(r0);
#pragma unroll
            for (int ai = 0; ai < 2; ++ai)
#pragma unroll
                for (int m = 0; m < 4; ++m) { const float rs = __builtin_amdgcn_rsqf((float)ldg<unsigned long long>(rsb, r0 + (unsigned)((ai * HALF + m * 16) * 8)) * (1.f / (4096.f * 16777216.f)) + 1e-6f);
#pragma unroll
                    for (int bj = 0; bj < 2; ++bj)
#pragma unroll
                        for (int n = 0; n < 2; ++n) stg<f32x4>(ob, l0 + (unsigned)((ai * HALF + m * 16) * 512 + bj * HALF + n * 16) * 4u, acc[ai][bj][m][n] * rs); }
        } else { char* ob = (char*)(u.aux ? kv1 : kv0) + ((size_t)u.pm * BM * 1024 + (size_t)u.pn * BM) * 2;
            PG8_OPAQUE(ob);
            unsigned l0 = ((unsigned)(wr * 64 + fr) * 1024u + (unsigned)(wc * 32 + 4 * fq)) * 2u; PG8_PIN(l0);
#pragma unroll
            for (int ai = 0; ai < 2; ++ai)
#pragma unroll
                for (int m = 0; m < 4; ++m)
#pragma unroll
                    for (int bj = 0; bj < 2; ++bj)
#pragma unroll
                        for (int n = 0; n < 2; ++n) { const f32x4 v = acc[ai][bj][m][n]; u32x2 w; w.x = cvt_pk_bf16(v[0], v[1]); w.y = cvt_pk_bf16(v[2], v[3]);
                            stg<u32x2>(ob, l0 + (unsigned)((ai * HALF + m * 16) * 1024 + bj * HALF + n * 16) * 2u, w); }
        }
    }
};

struct EpiGates {
    static constexpr bool PERM = false;
    const bf16_t* uc; const float* ba[2]; const float* bi[2]; const float* sp8[2]; unsigned* G;
    __device__ __forceinline__ void operator()(const f32x4 (&acc)[2][2][4][2], const Unit& u, int wr, int wc, int fr, int fq) const {
        const int dir = u.aux >> 5, nb = (u.aux >> 1) & 15, half = u.aux & 1;
        const int chu = nb * 256 + half * 128;
        const char* bap = (const char*)(dir ? ba[1] : ba[0]) + chu * 4; const char* bip = (const char*)(dir ? bi[1] : bi[0]) + chu * 4; const char* spp = (const char*)(dir ? sp8[1] : sp8[0]) + chu * 4;
        const char* ucb = (const char*)uc + ((size_t)u.pm * BM * 4096 + chu) * 2;
        char* gb = (char*)G + ((size_t)dir * ((size_t)8192 * 4096) + (size_t)u.pm * BM * 4096 + chu) * 4;
        PG8_OPAQUE(bap); PG8_OPAQUE(bip); PG8_OPAQUE(spp); PG8_OPAQUE(ucb); PG8_OPAQUE(gb);
        unsigned chl = (unsigned)(wc * 32 + 4 * fq), rl = (unsigned)(wr * 64 + fr) * 4096u; PG8_PIN(chl); PG8_PIN(rl);
#pragma unroll
        for (int n = 0; n < 2; ++n) { const unsigned c = chl + 16u * n;
            const f32x4 vba = ldg<f32x4>(bap, c * 4u), vbi = ldg<f32x4>(bip, c * 4u), vsp = ldg<f32x4>(spp, c * 4u);
            u32x2 uwv[2][4];
#pragma unroll
            for (int ai = 0; ai < 2; ++ai)
#pragma unroll
                for (int m = 0; m < 4; ++m) uwv[ai][m] = ldg<u32x2>(ucb, (rl + (unsigned)((ai * HALF + m * 16) * 4096) + c) * 2u);
            asm volatile("" ::: "memory");
#pragma unroll
            for (int ai = 0; ai < 2; ++ai)
#pragma unroll
                for (int m = 0; m < 4; ++m) { const unsigned eo = rl + (unsigned)((ai * HALF + m * 16) * 4096) + c;
                    const u32x2 uw = uwv[ai][m]; const float uv[4] = {bf_lo(uw.x), bf_hi(uw.x), bf_lo(uw.y), bf_hi(uw.y)};
                    f32x4 pa = acc[ai][0][m][n], pi = acc[ai][1][m][n]; asm volatile("" : "+v"(pa), "+v"(pi));
                    pa += vba; pi += vbi; u32x4 w;
#pragma unroll
                    for (int j = 0; j < 4; ++j) {
                        const float r = __builtin_amdgcn_rcpf(1.f + __builtin_amdgcn_exp2f(-1.4426950408889634f * pa[j]));
                        const float ig = __builtin_amdgcn_rcpf(1.f + __builtin_amdgcn_exp2f(-1.4426950408889634f * pi[j]));
                        const float la = -r * vsp[j];
                        const float x = 2.f * la;
                        const float ser = -x * (1.f + x * (0.5f + x * (1.f / 6.f)));
                        const float om = (x > -0.03125f) ? ser : 1.f - __builtin_amdgcn_exp2f(1.4426950408889634f * x);
                        const float inp = __builtin_amdgcn_sqrtf(om) * (ig * uv[j]);
                        w[j] = cvt_pk_bf16(la, inp); }
                    stg<u32x4>(gb, eo * 4u, w); } }
    }
};

template <class Epi, class Sched, bool ALIGN_EPI>
__device__ __forceinline__ void gemm_phase(PG8_LAS unsigned char* lds, const unsigned lda, const unsigned ldb, const Sched& S, const Epi& E, const int wave_id) {
    int tid = wave_id * 64 + lane_now(); asm volatile("" : "+v"(tid));
    const int wid = __builtin_amdgcn_readfirstlane(tid >> 6), lane = tid & 63, wr = wid >> 2, wc = wid & 3, fr = lane & 15, fq = lane >> 4;
    unsigned voffA[2], voffB[2];
#pragma unroll
    for (int i = 0; i < 2; ++i) { int R, C; stage_rc(tid * 16 + i * 8192, R, C); const int Rb = Epi::PERM ? ((R & ~31) + perm32(R & 31)) : R;
        voffA[i] = (unsigned)R * lda + (unsigned)C * 2u; voffB[i] = (unsigned)Rb * ldb + (unsigned)C * 2u; }
    const size_t kstep = (size_t)(BK * 2);
    const size_t hstepA = (size_t)HALF * lda, hstepB = (size_t)HALF * ldb;
    const unsigned ldsw = (unsigned)wid * 1024u;
    const int aoff = lds_byte(wr * 64 + fr, fq * 8), boff = lds_byte(wc * 32 + fr, fq * 8);
#define PG8_SA(b, h) (((b) * 2 + (h)) * HTB)
#define PG8_SB(b, h) ((4 + (b) * 2 + (h)) * HTB)
#define PG8_STAGE(bufoff, gbase, voff) do { _Pragma("unroll") for (int _i = 0; _i < 2; ++_i) \
        __builtin_amdgcn_global_load_lds((const unsigned*)((const char*)(gbase) + (voff)[_i]), (PG8_LAS unsigned*)(lds + (bufoff) + ldsw + _i * 8192), 16, 0, 0); } while (0)
#define PG8_LDA(dst, b, h) do { _Pragma("unroll") for (int m = 0; m < 4; ++m) _Pragma("unroll") for (int k = 0; k < 2; ++k) dst[m][k] = *(const PG8_LAS bf16x8*)(lds + PG8_SA(b, h) + aoff + m * 2048 + k * 1024); } while (0)
#define PG8_LDB(dst, b, h) do { _Pragma("unroll") for (int n = 0; n < 2; ++n) _Pragma("unroll") for (int k = 0; k < 2; ++k) dst[n][k] = *(const PG8_LAS bf16x8*)(lds + PG8_SB(b, h) + boff + n * 2048 + k * 1024); } while (0)
#define PG8_MMA(ai, bj, At, Bt) do { __builtin_amdgcn_s_setprio(1); _Pragma("unroll") for (int m = 0; m < 4; ++m) _Pragma("unroll") for (int n = 0; n < 2; ++n) _Pragma("unroll") for (int k = 0; k < 2; ++k) \
        acc[ai][bj][m][n] = __builtin_amdgcn_mfma_f32_16x16x32_bf16(Bt[n][k], At[m][k], acc[ai][bj][m][n], 0, 0, 0); __builtin_amdgcn_s_setprio(0); } while (0)
#define PG8_WAIT_V(n) asm volatile("s_waitcnt vmcnt(" #n ")" ::: "memory")
#define PG8_WAIT_L(n) asm volatile("s_waitcnt lgkmcnt(" #n ")" ::: "memory")
#define PG8_BAR __builtin_amdgcn_s_barrier()
#define PG8_SCHED __builtin_amdgcn_sched_barrier(0)
    Unit cur, nxt; int ui = 0;
    if (!S.next(0, cur)) return;
    f32x4 acc[2][2][4][2];
#pragma unroll
    for (int a = 0; a < 2; ++a)
#pragma unroll
        for (int b = 0; b < 2; ++b)
#pragma unroll
            for (int m = 0; m < 4; ++m)
#pragma unroll
                for (int n = 0; n < 2; ++n) acc[a][b][m][n] = (f32x4){0.f, 0.f, 0.f, 0.f};
    bf16x8 At[4][2], B0[2][2], B1[2][2];
    const char* cA = cur.A; const char* cB = cur.B;
    PG8_STAGE(PG8_SB(0, 0), cB, voffB); PG8_STAGE(PG8_SB(0, 1), cB + hstepB, voffB); PG8_STAGE(PG8_SA(0, 0), cA, voffA); PG8_STAGE(PG8_SA(0, 1), cA + hstepA, voffA);
    if (wr == 1) PG8_BAR;
    PG8_WAIT_V(2); PG8_BAR;
    PG8_STAGE(PG8_SB(1, 0), cB + kstep, voffB); PG8_STAGE(PG8_SA(1, 0), cA + kstep, voffA); PG8_STAGE(PG8_SB(1, 1), cB + hstepB + kstep, voffB);
    PG8_WAIT_V(6); PG8_BAR;
    for (;;) {
        const bool has_next = S.next(ui + 1, nxt);
        const char* nA = has_next ? nxt.A : cA; const char* nB = has_next ? nxt.B : cB;
        int nt = cur.nt; asm volatile("" : "+s"(nt));
        for (int t = 0; t < nt; t += 2) {
            const bool last = (t == nt - 2);
            const char* a1 = cA + (size_t)(t + 1) * kstep;
            const char* a2 = last ? nA : cA + (size_t)(t + 2) * kstep; const char* b2 = last ? nB : cB + (size_t)(t + 2) * kstep;
            const char* a3 = a2 + kstep; const char* b3 = b2 + kstep;
            PG8_LDB(B0, 0, 0); PG8_LDB(B1, 0, 1); PG8_SCHED; PG8_LDA(At, 0, 0); PG8_STAGE(PG8_SA(1, 1), a1 + hstepA, voffA);
            PG8_WAIT_V(8); PG8_WAIT_L(0); PG8_BAR; PG8_MMA(0, 0, At, B0); PG8_MMA(0, 1, At, B1); PG8_BAR; PG8_SCHED;
            PG8_LDA(At, 0, 1); PG8_STAGE(PG8_SB(0, 0), b2, voffB); PG8_STAGE(PG8_SB(0, 1), b2 + hstepB, voffB); PG8_STAGE(PG8_SA(0, 0), a2, voffA);
            PG8_WAIT_V(8); PG8_WAIT_L(0); PG8_BAR; PG8_MMA(1, 0, At, B0); PG8_MMA(1, 1, At, B1); PG8_BAR; PG8_SCHED;
            PG8_LDB(B0, 1, 0); PG8_LDB(B1, 1, 1); PG8_SCHED; PG8_LDA(At, 1, 0); PG8_STAGE(PG8_SA(0, 1), a2 + hstepA, voffA);
            PG8_WAIT_V(8); PG8_WAIT_L(0); PG8_BAR; PG8_MMA(0, 0, At, B0); PG8_MMA(0, 1, At, B1); PG8_BAR; PG8_SCHED;
            PG8_LDA(At, 1, 1); PG8_STAGE(PG8_SB(1, 0), b3, voffB); PG8_STAGE(PG8_SB(1, 1), b3 + hstepB, voffB); PG8_STAGE(PG8_SA(1, 0), a3, voffA);
            PG8_WAIT_V(8); PG8_WAIT_L(0); PG8_BAR; PG8_MMA(1, 0, At, B0); PG8_MMA(1, 1, At, B1); PG8_BAR; PG8_SCHED;
        }
        if constexpr (ALIGN_EPI) { if (wr == 0) PG8_BAR; }
        E(acc, cur, wr, wc, fr, fq);
        if (!has_next) break;
#pragma unroll
        for (int a = 0; a < 2; ++a)
#pragma unroll
            for (int b = 0; b < 2; ++b)
#pragma unroll
                for (int m = 0; m < 4; ++m)
#pragma unroll
                    for (int n = 0; n < 2; ++n) acc[a][b][m][n] = (f32x4){0.f, 0.f, 0.f, 0.f};
        cur = nxt; cA = nA; cB = nB; ++ui;
        if constexpr (ALIGN_EPI) { if (wr == 1) PG8_BAR; }
    }
    PG8_WAIT_V(0);
    if constexpr (!ALIGN_EPI) { if (wr == 0) PG8_BAR; }
    PG8_BAR;
#undef PG8_SA
#undef PG8_SB
#undef PG8_STAGE
#undef PG8_LDA
#undef PG8_LDB
#undef PG8_MMA
#undef PG8_WAIT_V
#undef PG8_WAIT_L
#undef PG8_BAR
#undef PG8_SCHED
}
}
namespace att {
using bf16x8 = __attribute__((ext_vector_type(8))) short;
using s16x4  = __attribute__((ext_vector_type(4))) short;
using f32x16 = __attribute__((ext_vector_type(16))) float;
using f32x8  = __attribute__((ext_vector_type(8))) float;
using u32x4  = __attribute__((ext_vector_type(4))) unsigned;
using f32x4  = __attribute__((ext_vector_type(4))) float;
typedef unsigned short bf16_t;
constexpr int D = 128, NW = 8, QBLK = 32, KVBLK = 64;
constexpr float SCALE = 0.088388347648318440f;
constexpr float THR = 8.f;
constexpr size_t SHM_V = KVBLK * D * 2, SHM_K = KVBLK * D * 2, SHM_ATTN = 2 * SHM_V + 2 * SHM_K + NW * 64 * 4;
#define KSWZ(row, colB) ((row) * 256 + ((colB) ^ (((row) & 15) << 4)))
#define SBAR() __builtin_amdgcn_sched_barrier(0)
__device__ __forceinline__ int crow(int r, int hi) { return (r & 3) + 8 * (r >> 2) + 4 * hi; }
__device__ __forceinline__ unsigned cvtpk(float lo, float hi) { unsigned r; asm volatile("v_cvt_pk_bf16_f32 %0, %1, %2" : "=v"(r) : "v"(lo), "v"(hi)); return r; }
__device__ __forceinline__ bf16x8 tobf(f32x8 x) { u32x4 w = {cvtpk(x[0], x[1]), cvtpk(x[2], x[3]), cvtpk(x[4], x[5]), cvtpk(x[6], x[7])}; return *reinterpret_cast<bf16x8*>(&w); }

__device__ __forceinline__ void partialSM(f32x16& p0, f32x16& p1, float& m_reg, float& mn, float& alpha) {
  constexpr float C = SCALE * 1.4426950408889634f;
  float pmax = p0[0]; for (int r = 1; r < 16; ++r) pmax = fmaxf(pmax, p0[r]); for (int r = 0; r < 16; ++r) pmax = fmaxf(pmax, p1[r]);
  { auto rr = __builtin_amdgcn_permlane32_swap(__float_as_uint(pmax), __float_as_uint(pmax), false, false);
    pmax = fmaxf(__uint_as_float(rr[0]), __uint_as_float(rr[1])); }
  if (__builtin_expect(__all(pmax - m_reg <= THR / SCALE), 1)) { mn = m_reg; alpha = 1.f; }
  else { mn = fmaxf(m_reg, pmax); alpha = __builtin_amdgcn_exp2f((m_reg - mn) * C); m_reg = mn; }
  float mnC = -mn * C;
  for (int r = 0; r < 16; ++r) p0[r] = fmaf(p0[r], C, mnC); for (int r = 0; r < 16; ++r) p1[r] = fmaf(p1[r], C, mnC);
  for (int r = 0; r < 16; ++r) p0[r] = __builtin_amdgcn_exp2f(p0[r]);
}
__device__ __forceinline__ void finishSM(f32x16& p0, f32x16& p1, float alpha, float& l_reg, bf16x8& pa0, bf16x8& pa1, bf16x8& pa2, bf16x8& pa3) {
  for (int r = 0; r < 16; ++r) p1[r] = __builtin_amdgcn_exp2f(p1[r]);
  float ps = 0; for (int r = 0; r < 16; ++r) ps += p0[r]; for (int r = 0; r < 16; ++r) ps += p1[r];
  { auto rr = __builtin_amdgcn_permlane32_swap(__float_as_uint(ps), __float_as_uint(ps), false, false);
    ps = __uint_as_float(rr[0]) + __uint_as_float(rr[1]); }
  l_reg = l_reg * alpha + ps;
#define PK4(P, BASE, OUT) do { unsigned a0 = cvtpk(P[BASE + 0], P[BASE + 1]), a1 = cvtpk(P[BASE + 2], P[BASE + 3]);   \
    unsigned b0 = cvtpk(P[BASE + 4], P[BASE + 5]), b1 = cvtpk(P[BASE + 6], P[BASE + 7]);                              \
    auto r0 = __builtin_amdgcn_permlane32_swap(a0, b0, false, false); auto r1 = __builtin_amdgcn_permlane32_swap(a1, b1, false, false); \
    u32x4 w = {r0[0], r1[0], r0[1], r1[1]}; OUT = *reinterpret_cast<bf16x8*>(&w); } while (0)
  PK4(p0, 0, pa0); PK4(p0, 8, pa1); PK4(p1, 0, pa2); PK4(p1, 8, pa3);
#undef PK4
}
__device__ __forceinline__ void qkt(f32x16& p0, f32x16& p1, const bf16_t* Ks, const bf16x8* qr, int r32, int hi) {
  p0 = f32x16{}; p1 = f32x16{};
#pragma unroll
  for (int d0 = 0; d0 < 8; ++d0) { int cb = (d0 * 16 + hi * 8) * 2;
    bf16x8 b0 = *reinterpret_cast<const bf16x8*>((const char*)Ks + KSWZ(r32, cb));
    bf16x8 b1 = *reinterpret_cast<const bf16x8*>((const char*)Ks + KSWZ(32 + r32, cb));
    p0 = __builtin_amdgcn_mfma_f32_32x32x16_bf16(b0, qr[d0], p0, 0, 0, 0);
    p1 = __builtin_amdgcn_mfma_f32_32x32x16_bf16(b1, qr[d0], p1, 0, 0, 0); }
}
__device__ __forceinline__ int v_st(int k, int c) { const int kk = (k & ~0xC) | ((k & 4) << 1) | ((k & 8) >> 1); return ((kk >> 3) * 4 + (c >> 5)) * 512 + ((kk & 7) * 32 + (c & 31)) * 2; }
__device__ __forceinline__ int v_rd_base(int lane) { return ((lane & 3) << 3) | (((lane >> 2) & 3) << 6) | (((lane >> 4) & 1) << 5) | (((lane >> 5) & 1) << 8); }
constexpr int v_rd_off(int d0, int ks, int half) { return d0 * 512 + ks * 4096 + half * 2048; }
template <int OFF> __device__ __forceinline__ s16x4 tr_read(int vb) {
  s16x4 r; asm volatile("ds_read_b64_tr_b16 %0, %1 offset:%2" : "=&v"(r) : "v"(vb), "i"(OFF) : "memory"); return r;
}
template <int D0> __device__ __forceinline__ void pv_one(f32x16& od, int vb, bf16x8 pa0, bf16x8 pa1, bf16x8 pa2, bf16x8 pa3) {
  const s16x4 l0 = tr_read<v_rd_off(D0, 0, 0)>(vb), h0 = tr_read<v_rd_off(D0, 0, 1)>(vb), l1 = tr_read<v_rd_off(D0, 1, 0)>(vb), h1 = tr_read<v_rd_off(D0, 1, 1)>(vb);
  const s16x4 l2 = tr_read<v_rd_off(D0, 2, 0)>(vb), h2 = tr_read<v_rd_off(D0, 2, 1)>(vb), l3 = tr_read<v_rd_off(D0, 3, 0)>(vb), h3 = tr_read<v_rd_off(D0, 3, 1)>(vb);
  asm volatile("s_waitcnt lgkmcnt(0)" ::: "memory"); SBAR();
#define PK(L, H) (bf16x8){L[0], L[1], L[2], L[3], H[0], H[1], H[2], H[3]}
  od = __builtin_amdgcn_mfma_f32_32x32x16_bf16(pa0, PK(l0, h0), od, 0, 0, 0);
  od = __builtin_amdgcn_mfma_f32_32x32x16_bf16(pa1, PK(l1, h1), od, 0, 0, 0);
  od = __builtin_amdgcn_mfma_f32_32x32x16_bf16(pa2, PK(l2, h2), od, 0, 0, 0);
  od = __builtin_amdgcn_mfma_f32_32x32x16_bf16(pa3, PK(l3, h3), od, 0, 0, 0);
#undef PK
}
__device__ __forceinline__ void pv_d0(f32x16* o, int vb, bf16x8 pa0, bf16x8 pa1, bf16x8 pa2, bf16x8 pa3) {
  pv_one<0>(o[0], vb, pa0, pa1, pa2, pa3); pv_one<1>(o[1], vb, pa0, pa1, pa2, pa3); pv_one<2>(o[2], vb, pa0, pa1, pa2, pa3); pv_one<3>(o[3], vb, pa0, pa1, pa2, pa3);
}

template <int QMODE, int OMODE, int LDQ, int LDK, int LDO, int SDEPTH>
__device__ __forceinline__ void attn_dense_body(const void* __restrict__ Qb_, size_t qslab, const bf16_t* __restrict__ Kh, const bf16_t* __restrict__ Vh,
                                                void* __restrict__ Ob_, int seq, char* lds, const int wave_id) {
  int tid = wave_id * 64 + pg8::lane_now(); asm volatile("" : "+v"(tid));
  const int wid = __builtin_amdgcn_readfirstlane(tid >> 6), lane = tid & 63, r32 = lane & 31, hi = lane >> 5;
  bf16_t* V_lds = (bf16_t*)lds; bf16_t* K_lds = (bf16_t*)(lds + 2 * SHM_V);
  float* ws = (float*)(lds + 2 * SHM_V + 2 * SHM_K) + wid * 64; float* li_l = ws; float* al_l = ws + 32;
  float m_reg = -1e30f, l_reg = 0; f32x16 o[4] = {}; bf16x8 qr[8];
  if constexpr (QMODE == 0) {
    const bf16_t* Qw = (const bf16_t*)Qb_ + (long)(wid * QBLK + r32) * LDQ + hi * 8;
#pragma unroll
    for (int d0 = 0; d0 < 8; ++d0) qr[d0] = *reinterpret_cast<const bf16x8*>(Qw + d0 * 16);
  } else {
    const float* Qw = (const float*)Qb_ + (long)(wid * QBLK + r32) * LDQ + hi * 8;
#pragma unroll
    for (int d0 = 0; d0 < 8; ++d0) { f32x8 a = *reinterpret_cast<const f32x8*>(Qw + d0 * 16);
#pragma unroll
      for (int s = 1; s < 4; ++s) a += *reinterpret_cast<const f32x8*>(Qw + s * qslab + d0 * 16);
      qr[d0] = tobf(a); if (d0 & 1) { asm volatile("" ::: "memory"); SBAR(); } }
  }
  const int sr = tid >> 4, sc = (tid & 15) * 8, vst0 = v_st(sr, sc), vst1 = v_st(32 + sr, sc);
  const int vb0 = (int)(uintptr_t)V_lds + v_rd_base(lane);
  struct { bf16x8 vs0, vs1, ks0, ks1; } sr_[SDEPTH];
#define SLOAD(i, k0) do { sr_[i].vs0 = *reinterpret_cast<const bf16x8*>(&Vh[(long)((k0) + sr) * LDK + sc]); sr_[i].vs1 = *reinterpret_cast<const bf16x8*>(&Vh[(long)((k0) + 32 + sr) * LDK + sc]); \
    sr_[i].ks0 = *reinterpret_cast<const bf16x8*>(&Kh[(long)((k0) + sr) * LDK + sc]); sr_[i].ks1 = *reinterpret_cast<const bf16x8*>(&Kh[(long)((k0) + 32 + sr) * LDK + sc]); } while (0)
#define SWRITE(b, i) do { *(bf16x8*)((char*)V_lds + (b) * SHM_V + vst0) = sr_[i].vs0;          \
    *(bf16x8*)((char*)V_lds + (b) * SHM_V + vst1) = sr_[i].vs1; int kc = sc * 2;               \
    *(bf16x8*)((char*)K_lds + (b) * SHM_K + KSWZ(sr, kc)) = sr_[i].ks0;                       \
    *(bf16x8*)((char*)K_lds + (b) * SHM_K + KSWZ(32 + sr, kc)) = sr_[i].ks1; } while (0)
#define SWAIT() do { if constexpr (SDEPTH == 2) asm volatile("s_waitcnt vmcnt(4)" ::: "memory"); else asm volatile("s_waitcnt vmcnt(0)" ::: "memory"); } while (0)
#define RESC(a) do { if (__any((a) < 1.f)) { if (hi == 0) al_l[r32] = (a); asm volatile("s_waitcnt lgkmcnt(0)" ::: "memory"); \
    for (int d = 0; d < 4; ++d) for (int r = 0; r < 16; ++r) o[d][r] *= al_l[crow(r, hi)]; } } while (0)
  f32x16 pA0, pA1, pB0, pB1; float mnA, mnB, alA, alB; bf16x8 pa0, pa1, pa2, pa3; const int NT = seq / KVBLK;
  constexpr int SE = 0, SO = SDEPTH - 1;
  SLOAD(SE, 0); asm volatile("s_waitcnt vmcnt(0)" ::: "memory"); SWRITE(0, SE); __syncthreads();
  qkt(pA0, pA1, K_lds, qr, r32, hi); partialSM(pA0, pA1, m_reg, mnA, alA);
  SLOAD(SO, KVBLK); if constexpr (SDEPTH == 2) { if (2 < NT) SLOAD(SE, 2 * KVBLK); }
  SWAIT(); SWRITE(1, SO); __syncthreads();
  for (int j = 1; j + 1 < NT; j += 2) {
    SBAR(); qkt(pB0, pB1, (bf16_t*)((char*)K_lds + SHM_K), qr, r32, hi);
    finishSM(pA0, pA1, alA, l_reg, pa0, pa1, pa2, pa3); SBAR();
    SLOAD(SO, (j + SDEPTH) * KVBLK); SBAR();
    pv_d0(o, vb0, pa0, pa1, pa2, pa3); partialSM(pB0, pB1, m_reg, mnB, alB);
    __syncthreads(); SWAIT(); SWRITE(0, SE);
    RESC(alB); __syncthreads();
    SBAR(); qkt(pA0, pA1, K_lds, qr, r32, hi);
    finishSM(pB0, pB1, alB, l_reg, pa0, pa1, pa2, pa3); SBAR();
    if (SDEPTH == 1 || j + 3 < NT) SLOAD(SE, (j + 1 + SDEPTH) * KVBLK); SBAR();
    pv_d0(o, vb0 + (int)SHM_V, pa0, pa1, pa2, pa3); partialSM(pA0, pA1, m_reg, mnA, alA);
    __syncthreads(); SWAIT(); SWRITE(1, SO);
    RESC(alA); __syncthreads();
  }
  SBAR(); qkt(pB0, pB1, (bf16_t*)((char*)K_lds + SHM_K), qr, r32, hi);
  finishSM(pA0, pA1, alA, l_reg, pa0, pa1, pa2, pa3); SBAR();
  pv_d0(o, vb0, pa0, pa1, pa2, pa3); partialSM(pB0, pB1, m_reg, mnB, alB);
  __syncthreads(); RESC(alB);
  finishSM(pB0, pB1, alB, l_reg, pa0, pa1, pa2, pa3); SBAR();
  pv_d0(o, vb0 + (int)SHM_V, pa0, pa1, pa2, pa3);
  if (hi == 0) li_l[r32] = l_reg; asm volatile("s_waitcnt lgkmcnt(0)" ::: "memory");
  float rli[16];
#pragma unroll
  for (int r = 0; r < 16; ++r) rli[r] = __builtin_amdgcn_rcpf(li_l[crow(r, hi)]);
  {
    constexpr unsigned ES = (OMODE == 0) ? 4u : 2u;
    char* Owb = (char*)Ob_ + (size_t)(wid * QBLK) * LDO * ES; asm volatile("" : "+s"(Owb));
    unsigned lo = ((unsigned)(4 * hi) * LDO + (unsigned)r32) * ES; asm volatile("" : "+v"(lo));
#pragma unroll
    for (int r = 0; r < 16; ++r) {
#pragma unroll
      for (int d0 = 0; d0 < 4; ++d0) { const unsigned off = lo + (unsigned)(((r & 3) + 8 * (r >> 2)) * LDO + d0 * 32) * ES; const float v = o[d0][r] * rli[r];
        if constexpr (OMODE == 0) *(__attribute__((address_space(1))) float*)((__attribute__((address_space(1))) char*)Owb + off) = v; else *(__attribute__((address_space(1))) bf16_t*)((__attribute__((address_space(1))) char*)Owb + off) = (bf16_t)(cvtpk(v, 0.f) & 0xffffu); } }
  }
  __syncthreads();
#undef SLOAD
#undef SWRITE
#undef SWAIT
#undef RESC
}

constexpr size_t KS_V = 0, KS_K = 65536, KS_X = 98304, KS_W = 114688, KS_BYTES = 118784;
template <int LDQ, int LDK, int LDO, int STAGE>
__device__ __forceinline__ void attn_ks_body(const bf16_t* __restrict__ Qb, const bf16_t* __restrict__ Kh, const bf16_t* __restrict__ Vh, bf16_t* __restrict__ Ob, int seq, char* lds, const int wave_id,
                                             unsigned (&o0p)[4][8], const float lam, const float* __restrict__ gain, const float post) {
  int tid = wave_id * 64 + pg8::lane_now(); asm volatile("" : "+v"(tid));
  const int wid = __builtin_amdgcn_readfirstlane(tid >> 6), lane = tid & 63, r32 = lane & 31, hi = lane >> 5, rg = wid & 3, kh = wid >> 2;
  char* V_lds = lds + KS_V; char* K_lds = lds + KS_K;
  char* Xown = lds + KS_X + wid * 2048; char* Xpar = lds + KS_X + (wid ^ 4) * 2048;
  float* wsf = (float*)(lds + KS_W) + wid * 128; float* wsp = (float*)(lds + KS_W) + (wid ^ 4) * 128;
  float m_reg = -1e30f, l_reg = 0.f; f32x16 o[4] = {}; bf16x8 qr[8];
  { const bf16_t* Qw = Qb + (long)(rg * QBLK + r32) * LDQ + hi * 8;
#pragma unroll
    for (int d0 = 0; d0 < 8; ++d0) qr[d0] = *reinterpret_cast<const bf16x8*>(Qw + d0 * 16); }
  const int sr = tid >> 4, sc = (tid & 15) * 8, vst0 = v_st(sr, sc), vst1 = v_st(32 + sr, sc);
  const int vb_own = (int)(uintptr_t)V_lds + kh * 16384 + v_rd_base(lane) + kh * 8192;
  const int vb_par = (int)(uintptr_t)V_lds + kh * 16384 + v_rd_base(lane) + (kh ^ 1) * 8192;
  bf16x8 ks0, ks1, va0, va1, vb0_, vb1_;
#define KS_SLOADK(k0) do { ks0 = *reinterpret_cast<const bf16x8*>(&Kh[(long)((k0) + sr) * LDK + sc]); ks1 = *reinterpret_cast<const bf16x8*>(&Kh[(long)((k0) + 32 + sr) * LDK + sc]); } while (0)
#define KS_SLOADV(k0) do { va0 = *reinterpret_cast<const bf16x8*>(&Vh[(long)((k0) + sr) * LDK + sc]); va1 = *reinterpret_cast<const bf16x8*>(&Vh[(long)((k0) + 32 + sr) * LDK + sc]); \
    vb0_ = *reinterpret_cast<const bf16x8*>(&Vh[(long)((k0) + sr) * LDK + 128 + sc]); vb1_ = *reinterpret_cast<const bf16x8*>(&Vh[(long)((k0) + 32 + sr) * LDK + 128 + sc]); } while (0)
#define KS_SWRITEK(b) do { const int kc = sc * 2; *(bf16x8*)(K_lds + (b) * 16384 + KSWZ(sr, kc)) = ks0; *(bf16x8*)(K_lds + (b) * 16384 + KSWZ(32 + sr, kc)) = ks1; } while (0)
#define KS_SWRITEV(b) do { *(bf16x8*)(V_lds + (b) * 32768 + vst0) = va0; *(bf16x8*)(V_lds + (b) * 32768 + vst1) = va1; \
    *(bf16x8*)(V_lds + (b) * 32768 + 16384 + vst0) = vb0_; *(bf16x8*)(V_lds + (b) * 32768 + 16384 + vst1) = vb1_; } while (0)
#define KS_QKT(P, b) do { P = f32x16{}; const char* kb_ = K_lds + (b) * 16384; \
    _Pragma("unroll") for (int d0 = 0; d0 < 8; ++d0) { const int cb = (d0 * 16 + hi * 8) * 2; \
      const bf16x8 bq = *reinterpret_cast<const bf16x8*>(kb_ + KSWZ(32 * kh + r32, cb)); P = __builtin_amdgcn_mfma_f32_32x32x16_bf16(bq, qr[d0], P, 0, 0, 0); } } while (0)
#define KS_PMAX(P) do { float pm_ = P[0]; _Pragma("unroll") for (int r = 1; r < 16; ++r) pm_ = fmaxf(pm_, P[r]); \
    { auto rr = __builtin_amdgcn_permlane32_swap(__float_as_uint(pm_), __float_as_uint(pm_), false, false); pm_ = fmaxf(__uint_as_float(rr[0]), __uint_as_float(rr[1])); } \
    pmax_own = pm_; if (hi == 0) wsf[r32] = pm_; } while (0)
#define KS_SOFTMAX(P) do { constexpr float C = SCALE * 1.4426950408889634f; \
    const float pmax = fmaxf(pmax_own, wsp[r32]); float mn; \
    if (__builtin_expect(__all(pmax - m_reg <= THR / SCALE), 1)) { mn = m_reg; alpha = 1.f; } \
    else { mn = fmaxf(m_reg, pmax); alpha = __builtin_amdgcn_exp2f((m_reg - mn) * C); m_reg = mn; } \
    const float mnC = -mn * C; \
    _Pragma("unroll") for (int r = 0; r < 16; ++r) P[r] = __builtin_amdgcn_exp2f(fmaf(P[r], C, mnC)); \
    float ps = 0.f; _Pragma("unroll") for (int r = 0; r < 16; ++r) ps += P[r]; \
    { auto rr = __builtin_amdgcn_permlane32_swap(__float_as_uint(ps), __float_as_uint(ps), false, false); ps = __uint_as_float(rr[0]) + __uint_as_float(rr[1]); } \
    l_reg = l_reg * alpha + ps; \
    { unsigned a0 = cvtpk(P[0], P[1]), a1 = cvtpk(P[2], P[3]), b0 = cvtpk(P[4], P[5]), b1 = cvtpk(P[6], P[7]); \
      auto r0 = __builtin_amdgcn_permlane32_swap(a0, b0, false, false); auto r1 = __builtin_amdgcn_permlane32_swap(a1, b1, false, false); u32x4 w = {r0[0], r1[0], r0[1], r1[1]}; nown0 = *reinterpret_cast<bf16x8*>(&w); } \
    { unsigned a0 = cvtpk(P[8], P[9]), a1 = cvtpk(P[10], P[11]), b0 = cvtpk(P[12], P[13]), b1 = cvtpk(P[14], P[15]); \
      auto r0 = __builtin_amdgcn_permlane32_swap(a0, b0, false, false); auto r1 = __builtin_amdgcn_permlane32_swap(a1, b1, false, false); u32x4 w = {r0[0], r1[0], r0[1], r1[1]}; nown1 = *reinterpret_cast<bf16x8*>(&w); } \
    *(bf16x8*)(Xown + lane * 32) = nown0; *(bf16x8*)(Xown + lane * 32 + 16) = nown1; } while (0)
#define KS_RESC() do { if (__any(alpha < 1.f)) { if (hi == 0) wsf[32 + r32] = alpha; asm volatile("s_waitcnt lgkmcnt(0)" ::: "memory"); \
      _Pragma("unroll") for (int d = 0; d < 4; ++d) _Pragma("unroll") for (int r = 0; r < 16; ++r) o[d][r] *= wsf[32 + crow(r, hi)]; } } while (0)
#define KS_PVD(D0, b) do { const int o_ = vb_own + (b) * 32768, p_ = vb_par + (b) * 32768; \
    const s16x4 l0 = tr_read<v_rd_off(D0, 0, 0)>(o_), h0 = tr_read<v_rd_off(D0, 0, 1)>(o_), l1 = tr_read<v_rd_off(D0, 1, 0)>(o_), h1 = tr_read<v_rd_off(D0, 1, 1)>(o_); \
    const s16x4 l2 = tr_read<v_rd_off(D0, 0, 0)>(p_), h2 = tr_read<v_rd_off(D0, 0, 1)>(p_), l3 = tr_read<v_rd_off(D0, 1, 0)>(p_), h3 = tr_read<v_rd_off(D0, 1, 1)>(p_); \
    asm volatile("s_waitcnt lgkmcnt(0)" ::: "memory"); SBAR(); \
    o[D0] = __builtin_amdgcn_mfma_f32_32x32x16_bf16(own0, ((bf16x8){l0[0], l0[1], l0[2], l0[3], h0[0], h0[1], h0[2], h0[3]}), o[D0], 0, 0, 0); \
    o[D0] = __builtin_amdgcn_mfma_f32_32x32x16_bf16(own1, ((bf16x8){l1[0], l1[1], l1[2], l1[3], h1[0], h1[1], h1[2], h1[3]}), o[D0], 0, 0, 0); \
    o[D0] = __builtin_amdgcn_mfma_f32_32x32x16_bf16(par0, ((bf16x8){l2[0], l2[1], l2[2], l2[3], h2[0], h2[1], h2[2], h2[3]}), o[D0], 0, 0, 0); \
    o[D0] = __builtin_amdgcn_mfma_f32_32x32x16_bf16(par1, ((bf16x8){l3[0], l3[1], l3[2], l3[3], h3[0], h3[1], h3[2], h3[3]}), o[D0], 0, 0, 0); } while (0)
#define KS_PV(b) do { KS_PVD(0, b); KS_PVD(1, b); KS_PVD(2, b); KS_PVD(3, b); } while (0)
  f32x16 S; float pmax_own, alpha = 1.f; bf16x8 own0, own1, par0, par1, nown0, nown1; const int NT = seq / KVBLK;
  KS_SLOADK(0); KS_SLOADV(0); asm volatile("s_waitcnt vmcnt(0)" ::: "memory"); KS_SWRITEK(0); KS_SWRITEV(0); __syncthreads();
  KS_QKT(S, 0); KS_PMAX(S); KS_SLOADK(KVBLK); KS_SLOADV(KVBLK);
  __syncthreads();
  KS_SWRITEK(1); KS_SOFTMAX(S); KS_RESC(); own0 = nown0; own1 = nown1;
  __syncthreads();
  for (int t = 0; t + 1 < NT; ++t) {
    const int bt = t & 1, bn = bt ^ 1;
    KS_SWRITEV(bn);
    SBAR(); KS_QKT(S, bn);
    par0 = *(const bf16x8*)(Xpar + lane * 32); par1 = *(const bf16x8*)(Xpar + lane * 32 + 16);
    SBAR(); if (t + 2 < NT) KS_SLOADK((t + 2) * KVBLK); SBAR();
    KS_PVD(0, bt); KS_PVD(1, bt); KS_PMAX(S);
    __syncthreads();
    if (t + 2 < NT) { KS_SWRITEK(bt); KS_SLOADV((t + 2) * KVBLK); }
    KS_PVD(2, bt); KS_PVD(3, bt);
    KS_SOFTMAX(S);
    KS_RESC(); own0 = nown0; own1 = nown1;
    __syncthreads();
  }
  { const int bl = (NT - 1) & 1;
    par0 = *(const bf16x8*)(Xpar + lane * 32); par1 = *(const bf16x8*)(Xpar + lane * 32 + 16);
    SBAR(); KS_PV(bl); }
  if (hi == 0) wsf[r32] = l_reg;
  __syncthreads();
  { const float lt = l_reg + wsp[r32]; if (hi == 0) wsf[64 + r32] = lt; asm volatile("s_waitcnt lgkmcnt(0)" ::: "memory"); }
  float rli[16];
#pragma unroll
  for (int r = 0; r < 16; ++r) rli[r] = __builtin_amdgcn_rcpf(wsf[64 + crow(r, hi)]);
  if constexpr (STAGE == 0) {
#pragma unroll
    for (int d0 = 0; d0 < 4; ++d0)
#pragma unroll
      for (int i = 0; i < 8; ++i) o0p[d0][i] = cvtpk(o[d0][2 * i] * rli[2 * i], o[d0][2 * i + 1] * rli[2 * i + 1]);
  } else {
    float ssq[16];
#pragma unroll
    for (int r = 0; r < 16; ++r) ssq[r] = 0.f;
#pragma unroll
    for (int d0 = 0; d0 < 4; ++d0)
#pragma unroll
      for (int i = 0; i < 8; ++i) { const unsigned w = o0p[d0][i];
        const float da = __uint_as_float(w << 16) - lam * (o[d0][2 * i] * rli[2 * i]), db = __uint_as_float(w & 0xffff0000u) - lam * (o[d0][2 * i + 1] * rli[2 * i + 1]);
        o[d0][2 * i] = da; o[d0][2 * i + 1] = db; ssq[2 * i] += da * da; ssq[2 * i + 1] += db * db; }
    float* T = (float*)(K_lds + wid * 4096);
#pragma unroll
    for (int r = 0; r < 16; ++r) T[crow(r, hi) * 32 + r32] = ssq[r];
    asm volatile("s_waitcnt lgkmcnt(0)" ::: "memory");
    float tot = 0.f;
    { const f32x4* tp = (const f32x4*)(T + r32 * 32 + 16 * hi);
#pragma unroll
      for (int q = 0; q < 4; ++q) { const f32x4 v = tp[q]; tot += (v[0] + v[1]) + (v[2] + v[3]); } }
    { auto rr = __builtin_amdgcn_permlane32_swap(__float_as_uint(tot), __float_as_uint(tot), false, false); tot = __uint_as_float(rr[0]) + __uint_as_float(rr[1]); }
    __syncthreads();
    if (hi == 0) wsf[r32] = tot;
    __syncthreads();
    { const float ta = tot + wsp[r32]; if (hi == 0) wsf[64 + r32] = __builtin_amdgcn_rsqf(ta * (1.f / 256.f) + 1e-6f) * post; asm volatile("s_waitcnt lgkmcnt(0)" ::: "memory"); }
    float gv[4];
#pragma unroll
    for (int d0 = 0; d0 < 4; ++d0) gv[d0] = gain[kh * 128 + d0 * 32 + r32];
    char* Owb = (char*)Ob + ((size_t)(rg * QBLK) * LDO + (size_t)kh * 128) * 2u; asm volatile("" : "+s"(Owb));
    unsigned lo = ((unsigned)(4 * hi) * LDO + (unsigned)r32) * 2u; asm volatile("" : "+v"(lo));
#pragma unroll
    for (int r = 0; r < 16; ++r) { const float rs = wsf[64 + crow(r, hi)];
#pragma unroll
      for (int d0 = 0; d0 < 4; ++d0) { const unsigned off = lo + (unsigned)(((r & 3) + 8 * (r >> 2)) * LDO + d0 * 32) * 2u;
        *(__attribute__((address_space(1))) bf16_t*)((__attribute__((address_space(1))) char*)Owb + off) = (bf16_t)(cvtpk(o[d0][r] * rs * gv[d0], 0.f) & 0xffffu); } }
  }
  __syncthreads();
#undef KS_SLOADK
#undef KS_SLOADV
#undef KS_SWRITEK
#undef KS_SWRITEV
#undef KS_RESC
#undef KS_QKT
#undef KS_PMAX
#undef KS_SOFTMAX
#undef KS_PVD
#undef KS_PV
}

constexpr size_t K1_V = 0, K1_K = 65536, K1_X = 98304, K1_W = 132096;
template <int LDQ, int LDK, int LDO, int STAGE, unsigned VH2>
__device__ __forceinline__ void attn_ks1_body(const bf16_t* __restrict__ Qb, const bf16_t* __restrict__ Kh, const bf16_t* __restrict__ Vh, bf16_t* __restrict__ Ob, int seq, char* lds, const int wave_id,
                                              unsigned (&o0p)[4][8], const float lam, const float* __restrict__ gain, const float post) {
  int tid = wave_id * 64 + pg8::lane_now(); asm volatile("" : "+v"(tid));
  const int wid = __builtin_amdgcn_readfirstlane(tid >> 6), lane = tid & 63, r32 = lane & 31, hi = lane >> 5, rg = wid & 3, kh = wid >> 2;
  char* V_lds = lds + K1_V; char* K_lds = lds + K1_K;
  char* Xown = lds + K1_X + wid * 2048; char* Xpar = lds + K1_X + (wid ^ 4) * 2048;
  float* wsf = (float*)(lds + K1_W) + wid * 128; float* wsp = (float*)(lds + K1_W) + (wid ^ 4) * 128;
  float m_reg = -1e30f, l_reg = 0.f; f32x16 o[4] = {}; bf16x8 qr[8];
  { const bf16_t* Qw = Qb + (long)(rg * QBLK + r32) * LDQ + hi * 8;
#pragma unroll
    for (int d0 = 0; d0 < 8; ++d0) qr[d0] = *reinterpret_cast<const bf16x8*>(Qw + d0 * 16); }
  const int sr = tid >> 4, sc = (tid & 15) * 8;
  const int vrow = (wid << 2) | ((lane >> 5) << 1) | ((lane >> 2) & 1), vcol = ((lane >> 3) & 3) * 32 + (lane & 3) * 8, vst0 = v_st(vrow, vcol), vst1 = v_st(32 + vrow, vcol);
  const int vb_own = (int)(uintptr_t)V_lds + kh * 16384 + v_rd_base(lane) + kh * 8192;
  const int vb_par = (int)(uintptr_t)V_lds + kh * 16384 + v_rd_base(lane) + (kh ^ 1) * 8192;
  bf16x8 ks0, ks1, va0, va1, vb0_, vb1_;
  unsigned kvo0 = (unsigned)(sr * LDK + sc) * 2u, vvo0 = (unsigned)(vrow * LDK + vcol) * 2u; asm volatile("" : "+v"(kvo0), "+v"(vvo0));
#define K1_GLD(base, off) (*(const __attribute__((address_space(1))) bf16x8*)((const __attribute__((address_space(1))) char*)(base) + (off)))
#define K1_LOADK(k0) do { const char* kb__ = (const char*)Kh + (size_t)(k0) * LDK * 2; const char* kb2__ = kb__ + 32 * LDK * 2; asm volatile("" : "+s"(kb__), "+s"(kb2__), "+v"(kvo0)); ks0 = K1_GLD(kb__, kvo0); ks1 = K1_GLD(kb2__, kvo0); } while (0)
#define K1_LOADV(k0) do { const char* vb__ = (const char*)Vh + (size_t)(k0) * LDK * 2; const char* vc__ = vb__ + VH2; const char* vb2__ = vb__ + 32 * LDK * 2; const char* vc2__ = vc__ + 32 * LDK * 2; asm volatile("" : "+s"(vb__), "+s"(vc__), "+s"(vb2__), "+s"(vc2__), "+v"(vvo0)); va0 = K1_GLD(vb__, vvo0); va1 = K1_GLD(vb2__, vvo0); vb0_ = K1_GLD(vc__, vvo0); vb1_ = K1_GLD(vc2__, vvo0); } while (0)
#define K1_WRITEK(b) do { const int kc = sc * 2; *(bf16x8*)(K_lds + (b) * 16384 + KSWZ(sr, kc)) = ks0; *(bf16x8*)(K_lds + (b) * 16384 + KSWZ(32 + sr, kc)) = ks1; } while (0)
#define K1_WRITEV(b) do { *(bf16x8*)(V_lds + (b) * 32768 + vst0) = va0; *(bf16x8*)(V_lds + (b) * 32768 + vst1) = va1; \
    *(bf16x8*)(V_lds + (b) * 32768 + 16384 + vst0) = vb0_; *(bf16x8*)(V_lds + (b) * 32768 + 16384 + vst1) = vb1_; } while (0)
#define K1_QKT(P, b) do { P = f32x16{}; const char* kb_ = K_lds + (b) * 16384; \
    _Pragma("unroll") for (int d0 = 0; d0 < 8; ++d0) { const int cb = (d0 * 16 + hi * 8) * 2; \
      const bf16x8 bq = *reinterpret_cast<const bf16x8*>(kb_ + KSWZ(32 * kh + r32, cb)); P = __builtin_amdgcn_mfma_f32_32x32x16_bf16(bq, qr[d0], P, 0, 0, 0); } } while (0)
#define K1_PMAX(P, PM, par_) do { float pm_ = P[0]; _Pragma("unroll") for (int r = 1; r < 16; ++r) pm_ = fmaxf(pm_, P[r]); \
    { auto rr = __builtin_amdgcn_permlane32_swap(__float_as_uint(pm_), __float_as_uint(pm_), false, false); pm_ = fmaxf(__uint_as_float(rr[0]), __uint_as_float(rr[1])); } \
    PM = pm_; if (hi == 0) wsf[32 * (par_) + r32] = pm_; } while (0)
#define K1_SOFTMAX(P, PMO, PMP, par_) do { constexpr float C = SCALE * 1.4426950408889634f; \
    const float pmax = fmaxf((PMO), (PMP)); float mn; \
    if (__builtin_expect(__all(pmax - m_reg <= THR / SCALE), 1)) { mn = m_reg; alpha = 1.f; } \
    else { mn = fmaxf(m_reg, pmax); alpha = __builtin_amdgcn_exp2f((m_reg - mn) * C); m_reg = mn; } \
    const float mnC = -mn * C; \
    _Pragma("unroll") for (int r = 0; r < 16; ++r) P[r] = __builtin_amdgcn_exp2f(fmaf(P[r], C, mnC)); \
    float ps = 0.f; _Pragma("unroll") for (int r = 0; r < 16; ++r) ps += P[r]; \
    { auto rr = __builtin_amdgcn_permlane32_swap(__float_as_uint(ps), __float_as_uint(ps), false, false); ps = __uint_as_float(rr[0]) + __uint_as_float(rr[1]); } \
    l_reg = l_reg * alpha + ps; \
    { unsigned a0 = cvtpk(P[0], P[1]), a1 = cvtpk(P[2], P[3]), b0 = cvtpk(P[4], P[5]), b1 = cvtpk(P[6], P[7]); \
      auto r0 = __builtin_amdgcn_permlane32_swap(a0, b0, false, false); auto r1 = __builtin_amdgcn_permlane32_swap(a1, b1, false, false); u32x4 w = {r0[0], r1[0], r0[1], r1[1]}; nown0 = *reinterpret_cast<bf16x8*>(&w); } \
    { unsigned a0 = cvtpk(P[8], P[9]), a1 = cvtpk(P[10], P[11]), b0 = cvtpk(P[12], P[13]), b1 = cvtpk(P[14], P[15]); \
      auto r0 = __builtin_amdgcn_permlane32_swap(a0, b0, false, false); auto r1 = __builtin_amdgcn_permlane32_swap(a1, b1, false, false); u32x4 w = {r0[0], r1[0], r0[1], r1[1]}; nown1 = *reinterpret_cast<bf16x8*>(&w); } \
    *(bf16x8*)(Xown + (par_) * 16384 + lane * 16) = nown0; *(bf16x8*)(Xown + (par_) * 16384 + 1024 + lane * 16) = nown1; } while (0)
#define K1_RESC() do { if (__any(alpha < 1.f)) { if (hi == 0) wsf[64 + r32] = alpha; asm volatile("s_waitcnt lgkmcnt(0)" ::: "memory"); \
      _Pragma("unroll") for (int d = 0; d < 4; ++d) _Pragma("unroll") for (int r = 0; r < 16; ++r) o[d][r] *= wsf[64 + crow(r, hi)]; } } while (0)
#define K1_PVD(D0, b) do { const int o_ = vb_own + (b) * 32768, p_ = vb_par + (b) * 32768; \
    const s16x4 l0 = tr_read<v_rd_off(D0, 0, 0)>(o_), h0 = tr_read<v_rd_off(D0, 0, 1)>(o_), l1 = tr_read<v_rd_off(D0, 1, 0)>(o_), h1 = tr_read<v_rd_off(D0, 1, 1)>(o_); \
    const s16x4 l2 = tr_read<v_rd_off(D0, 0, 0)>(p_), h2 = tr_read<v_rd_off(D0, 0, 1)>(p_), l3 = tr_read<v_rd_off(D0, 1, 0)>(p_), h3 = tr_read<v_rd_off(D0, 1, 1)>(p_); \
    asm volatile("s_waitcnt lgkmcnt(0)" ::: "memory"); SBAR(); \
    o[D0] = __builtin_amdgcn_mfma_f32_32x32x16_bf16(own0, ((bf16x8){l0[0], l0[1], l0[2], l0[3], h0[0], h0[1], h0[2], h0[3]}), o[D0], 0, 0, 0); \
    o[D0] = __builtin_amdgcn_mfma_f32_32x32x16_bf16(own1, ((bf16x8){l1[0], l1[1], l1[2], l1[3], h1[0], h1[1], h1[2], h1[3]}), o[D0], 0, 0, 0); \
    o[D0] = __builtin_amdgcn_mfma_f32_32x32x16_bf16(par0, ((bf16x8){l2[0], l2[1], l2[2], l2[3], h2[0], h2[1], h2[2], h2[3]}), o[D0], 0, 0, 0); \
    o[D0] = __builtin_amdgcn_mfma_f32_32x32x16_bf16(par1, ((bf16x8){l3[0], l3[1], l3[2], l3[3], h3[0], h3[1], h3[2], h3[3]}), o[D0], 0, 0, 0); } while (0)
  f32x16 S1, S2; float pm1 = 0.f, pm2 = 0.f, alpha = 1.f; bf16x8 own0, own1, par0, par1, nown0, nown1; const int NT = seq / KVBLK;
  { bf16x8 kx0, kx1, ky0, ky1;
    K1_LOADK(0); K1_LOADV(0);
    { const char* kb__ = (const char*)Kh + (size_t)KVBLK * LDK * 2; const char* kb2__ = kb__ + 32 * LDK * 2; const char* kc__ = kb__ + (size_t)KVBLK * LDK * 2; const char* kc2__ = kc__ + 32 * LDK * 2;
      asm volatile("" : "+s"(kb__), "+s"(kb2__), "+s"(kc__), "+s"(kc2__), "+v"(kvo0));
      kx0 = K1_GLD(kb__, kvo0); kx1 = K1_GLD(kb2__, kvo0); ky0 = K1_GLD(kc__, kvo0); ky1 = K1_GLD(kc2__, kvo0); }
    asm volatile("s_waitcnt vmcnt(0)" ::: "memory");
    K1_WRITEK(0); K1_WRITEV(0);
    { const int kc = sc * 2; *(bf16x8*)(K_lds + 16384 + KSWZ(sr, kc)) = kx0; *(bf16x8*)(K_lds + 16384 + KSWZ(32 + sr, kc)) = kx1; }
    K1_LOADK(3 * KVBLK); K1_LOADV(KVBLK);
    __syncthreads();
    K1_QKT(S1, 0); K1_PMAX(S1, pm1, 0);
    __syncthreads();
    { const float pmp = wsp[32 * 0 + r32]; K1_SOFTMAX(S1, pm1, pmp, 0); K1_RESC(); own0 = nown0; own1 = nown1; }
    K1_QKT(S1, 1); K1_PMAX(S1, pm1, 1);
    { const int kc = sc * 2; *(bf16x8*)(K_lds + KSWZ(sr, kc)) = ky0; *(bf16x8*)(K_lds + KSWZ(32 + sr, kc)) = ky1; }
    __syncthreads(); }
  if (wid >= 4) __builtin_amdgcn_s_setprio(1);
#define K1_SEG(t, p, q) do { \
    par0 = *(const bf16x8*)(Xpar + p * 16384 + lane * 16); par1 = *(const bf16x8*)(Xpar + p * 16384 + 1024 + lane * 16); \
    const float pmp = wsp[32 * q + r32]; \
    if (t + 1 < NT) K1_WRITEV(q); \
    if (t + 3 < NT) K1_WRITEK(q); \
    if (t + 2 < NT) K1_LOADV((t + 2) * KVBLK); \
    if (t + 4 < NT) K1_LOADK((t + 4) * KVBLK); \
    K1_PVD(0, p); K1_PVD(1, p); K1_PVD(2, p); K1_PVD(3, p); \
    if (t + 1 < NT) { K1_SOFTMAX(S1, pm1, pmp, q); } else alpha = 1.f; \
    SBAR(); \
    if (t + 2 < NT) { K1_QKT(S2, p); K1_PMAX(S2, pm2, p); } \
    K1_RESC(); own0 = nown0; own1 = nown1; S1 = S2; pm1 = pm2; \
    __syncthreads(); \
  } while (0)
  for (int t = 0; t < NT; t += 2) { K1_SEG(t, 0, 1); K1_SEG(t + 1, 1, 0); }
#undef K1_SEG
  __builtin_amdgcn_s_setprio(0);
  if (hi == 0) wsf[96 + r32] = l_reg;
  __syncthreads();
  { const float lt = l_reg + wsp[96 + r32]; asm volatile("s_waitcnt lgkmcnt(0)" ::: "memory"); __syncthreads(); if (hi == 0) wsf[96 + r32] = lt; asm volatile("s_waitcnt lgkmcnt(0)" ::: "memory"); }
  float rli[16];
#pragma unroll
  for (int r = 0; r < 16; ++r) rli[r] = __builtin_amdgcn_rcpf(wsf[96 + crow(r, hi)]);
  if constexpr (STAGE == 0) {
#pragma unroll
    for (int d0 = 0; d0 < 4; ++d0)
#pragma unroll
      for (int i = 0; i < 8; ++i) o0p[d0][i] = cvtpk(o[d0][2 * i] * rli[2 * i], o[d0][2 * i + 1] * rli[2 * i + 1]);
  } else {
    float ssq[16];
#pragma unroll
    for (int r = 0; r < 16; ++r) ssq[r] = 0.f;
#pragma unroll
    for (int d0 = 0; d0 < 4; ++d0)
#pragma unroll
      for (int i = 0; i < 8; ++i) { const unsigned w = o0p[d0][i];
        const float da = __uint_as_float(w << 16) - lam * (o[d0][2 * i] * rli[2 * i]), db = __uint_as_float(w & 0xffff0000u) - lam * (o[d0][2 * i + 1] * rli[2 * i + 1]);
        o[d0][2 * i] = da; o[d0][2 * i + 1] = db; ssq[2 * i] += da * da; ssq[2 * i + 1] += db * db; }
    float* T = (float*)(K_lds + wid * 4096);
#pragma unroll
    for (int r = 0; r < 16; ++r) T[crow(r, hi) * 32 + r32] = ssq[r];
    asm volatile("s_waitcnt lgkmcnt(0)" ::: "memory");
    float tot = 0.f;
    { const f32x4* tp = (const f32x4*)(T + r32 * 32 + 16 * hi);
#pragma unroll
      for (int qq = 0; qq < 4; ++qq) { const f32x4 v = tp[qq]; tot += (v[0] + v[1]) + (v[2] + v[3]); } }
    { auto rr = __builtin_amdgcn_permlane32_swap(__float_as_uint(tot), __float_as_uint(tot), false, false); tot = __uint_as_float(rr[0]) + __uint_as_float(rr[1]); }
    if (hi == 0) wsf[r32] = tot;
    __syncthreads();
    { const float ta = tot + wsp[r32]; if (hi == 0) wsf[64 + r32] = __builtin_amdgcn_rsqf(ta * (1.f / 256.f) + 1e-6f) * post; asm volatile("s_waitcnt lgkmcnt(0)" ::: "memory"); }
    float gv[4];
#pragma unroll
    for (int d0 = 0; d0 < 4; ++d0) gv[d0] = gain[kh * 128 + d0 * 32 + r32];
    char* Owb = (char*)Ob + ((size_t)(rg * QBLK) * LDO + (size_t)kh * 128) * 2u; asm volatile("" : "+s"(Owb));
    unsigned lo = ((unsigned)(4 * hi) * LDO + (unsigned)r32) * 2u; asm volatile("" : "+v"(lo));
#pragma unroll
    for (int r = 0; r < 16; ++r) { const float rs = wsf[64 + crow(r, hi)];
#pragma unroll
      for (int d0 = 0; d0 < 4; ++d0) { const unsigned off = lo + (unsigned)(((r & 3) + 8 * (r >> 2)) * LDO + d0 * 32) * 2u;
        *(__attribute__((address_space(1))) bf16_t*)((__attribute__((address_space(1))) char*)Owb + off) = (bf16_t)(cvtpk(o[d0][r] * rs * gv[d0], 0.f) & 0xffffu); } }
  }
  __syncthreads();
#undef K1_GLD
#undef K1_LOADK
#undef K1_LOADV
#undef K1_WRITEK
#undef K1_WRITEV
#undef K1_QKT
#undef K1_PMAX
#undef K1_SOFTMAX
#undef K1_RESC
#undef K1_PVD
}
#undef KSWZ
#undef SBAR
}
constexpr int NWAVES = 8;
constexpr int DM = 4096, NB = 2, SEQ = 4096, M = NB * SEQ, NH = 16, MEMT = 256, XW = 512, DFF = 16384;
constexpr float EPS = 1e-6f;
constexpr float LAM_INIT0 = 0.2f;

constexpr size_t MiB = 1u << 20;
constexpr size_t WS_CTL = 0, CTL_ZERO_BYTES = 1 * MiB;
constexpr size_t WS_WQKV = 1 * MiB;
constexpr size_t WS_WO   = WS_WQKV + 96 * MiB;
constexpr size_t WS_WIN  = WS_WO + 32 * MiB;
constexpr size_t WS_WG   = WS_WIN + 64 * MiB;
constexpr size_t WS_WOUT = WS_WG + 8 * MiB;
constexpr size_t WS_WXQ  = WS_WOUT + 32 * MiB;
constexpr size_t WS_WXKV = WS_WXQ + 8 * MiB;
constexpr size_t WS_WXO  = WS_WXKV + 16 * MiB;
constexpr size_t WS_W1   = WS_WXO + 8 * MiB;
constexpr size_t WS_W2   = WS_W1 + 256 * MiB;
constexpr size_t WS_H    = WS_W2 + 256 * MiB;
constexpr size_t WS_XN   = WS_H + 128 * MiB;
constexpr size_t WS_QKV  = WS_XN + 64 * MiB;
constexpr size_t WS_R256 = WS_QKV + 192 * MiB;
constexpr size_t WS_ON   = WS_R256 + 256 * MiB;
constexpr size_t WS_Y    = WS_ON + 64 * MiB;
constexpr size_t WS_SLAB = WS_Y + 64 * MiB;
constexpr size_t WS_OX   = WS_SLAB + 64 * MiB;
constexpr size_t WS_KV   = WS_OX + 8 * MiB;
constexpr size_t WS_MEMN = WS_KV + 2 * MiB;
constexpr size_t WS_ROPE = WS_MEMN + 8 * MiB;
constexpr size_t WS_SP8  = WS_ROPE + 1 * MiB;
constexpr size_t WS_AGG  = WS_SP8 + 1 * MiB;
constexpr size_t WS_CARRY = WS_AGG + 8 * MiB;
constexpr size_t WS_END  = WS_CARRY + 4 * MiB;
static_assert(WS_END <= 1720 * MiB, "d_ws map");

constexpr int CW_BAR = 4096;
constexpr int RING_BYTES = 131072, LDSCTL_OFF = RING_BYTES, MISC_OFF = LDSCTL_OFF + 320, LDS_BYTES = 147456;

#define GAS __attribute__((address_space(1)))
#define LAS __attribute__((address_space(3)))
typedef unsigned short bf16;
typedef unsigned v4u __attribute__((ext_vector_type(4)));
typedef unsigned v2u __attribute__((ext_vector_type(2)));
typedef float f32x4 __attribute__((ext_vector_type(4)));
typedef float f32x2 __attribute__((ext_vector_type(2)));
#define LDS_WAIT() asm volatile("s_waitcnt lgkmcnt(0)" ::: "memory")
#define VM_WAIT() asm volatile("s_waitcnt vmcnt(0)" ::: "memory")
__device__ __forceinline__ unsigned pk2(float lo, float hi) { return pg8::cvt_pk_bf16(lo, hi); }
using pg8::bf_lo; using pg8::bf_hi;

#define XB_TMO      128
#define XB_XCNT(j)  (256  + 64 * (j))
#define XB_XSUB(j)  (1280 + 64 * (j))
#define XB_XGEN(j)  (2304 + 64 * (j))
#define XB_TOP      3328
#define XB_TOPGEN   3392
#define XCD_BAR_WORDS 3456
#define XB_SPIN_CAP (1u << 22)
__device__ __forceinline__ unsigned xb_ld(unsigned* p)              { return __hip_atomic_load(p, __ATOMIC_RELAXED, __HIP_MEMORY_SCOPE_AGENT); }
__device__ __forceinline__ unsigned xb_add(unsigned* p, unsigned v) { return __hip_atomic_fetch_add(p, v, __ATOMIC_RELAXED, __HIP_MEMORY_SCOPE_AGENT); }
__device__ __forceinline__ unsigned xb_xcc_id() { return (unsigned)__builtin_amdgcn_s_getreg((3 << 11) | 20) & 0xFu; }
#define XB_SPIN(cond, bar) do { unsigned _sp = 0; while (cond) { __builtin_amdgcn_s_sleep(1); \
    if ((++_sp & 255u) == 0u) { if (xb_ld(&(bar)[XB_TMO])) break; if (_sp > XB_SPIN_CAP) { atomicAdd(&(bar)[XB_TMO], 1u); break; } } } } while (0)
struct XcdBarrier { unsigned* bar; unsigned x; volatile LAS unsigned* st; };
__device__ __forceinline__ XcdBarrier xcd_barrier_post(unsigned* bar, volatile LAS unsigned* st) {
    XcdBarrier b; b.bar = bar; b.x = xb_xcc_id(); b.st = st;
    if (threadIdx.x == 0) (void)xb_add(&bar[XB_XCNT(b.x)], 1u);
    return b;
}
__device__ __forceinline__ void xcd_barrier_complete(unsigned* bar, unsigned x, unsigned& nloc, unsigned& nx) {
    const unsigned G = gridDim.x * gridDim.y * gridDim.z;
    unsigned sum, cnt, mine, sp = 0u;
    for (;;) {
        sum = 0u; cnt = 0u; mine = 0u;
#pragma unroll
        for (unsigned j = 0; j < 16; ++j) { const unsigned c = xb_ld(&bar[XB_XCNT(j)]); sum += c; cnt += (c > 0u) ? 1u : 0u; mine = (j == x) ? c : mine; }
        if (sum == G) break;
        __builtin_amdgcn_s_sleep(1);
        if ((++sp & 255u) == 0u) { if (xb_ld(&bar[XB_TMO])) break; if (sp > XB_SPIN_CAP) { atomicAdd(&bar[XB_TMO], 1u); break; } }
    }
    nloc = mine > 0u ? mine : 1u; nx = cnt > 0u ? cnt : 1u;
}
__device__ __forceinline__ void xcd_barrier_impl(unsigned* bar_, unsigned x_, volatile LAS unsigned* st_, int wave_id_) {
    XcdBarrier b; b.bar = bar_; b.x = x_; b.st = st_;
    asm volatile("s_waitcnt vmcnt(0)" ::: "memory");
    __syncthreads();
    int t0_ = wave_id_ * 64 + pg8::lane_now(); asm volatile("" : "+v"(t0_));
    { unsigned xo = b.x; asm volatile("" : "+s"(xo)); b.x = xo; }
    if (t0_ == 0) {
        unsigned* bar = b.bar; asm volatile("" : "+s"(bar));
        __builtin_amdgcn_s_waitcnt(0);
        unsigned nloc = b.st[0], nx = b.st[1];
        if (nloc == 0u) { xcd_barrier_complete(bar, b.x, nloc, nx); b.st[0] = nloc; b.st[1] = nx; }
        const unsigned old = xb_add(&bar[XB_XSUB(b.x)], 1u);
        const unsigned gen = old / nloc;
        if (old + 1u == (gen + 1u) * nloc) {
            __builtin_amdgcn_fence(__ATOMIC_RELEASE, "agent");
            asm volatile("s_waitcnt vmcnt(0)" ::: "memory");
            const unsigned og = xb_add(&bar[XB_TOP], 1u);
            const unsigned tg = og / nx;
            if (og + 1u == (tg + 1u) * nx) xb_add(&bar[XB_TOPGEN], 1u);
            else XB_SPIN(xb_ld(&bar[XB_TOPGEN]) == tg, bar);
            __builtin_amdgcn_fence(__ATOMIC_ACQUIRE, "agent");
            xb_add(&bar[XB_XGEN(b.x)], 1u);
            asm volatile("s_waitcnt vmcnt(0)" ::: "memory");
        } else {
            XB_SPIN(xb_ld(&bar[XB_XGEN(b.x)]) == gen, bar);
            __builtin_amdgcn_fence(__ATOMIC_ACQUIRE, "agent");
            asm volatile("s_waitcnt vmcnt(0)" ::: "memory");
        }
    }
    __syncthreads();
}
__device__ __forceinline__ void xcd_barrier(const XcdBarrier& b, int wave_id) { xcd_barrier_impl(b.bar, b.x, b.st, wave_id); }

struct Frame {
    LAS unsigned char* lds;
    int tid, lane, wave, vcu, G;
    int gw, NGW;
};

__device__ __forceinline__ float wave_sum(float v, int lane) {
#pragma unroll
    for (int o = 1; o < 64; o <<= 1) v += __builtin_bit_cast(float, __builtin_amdgcn_ds_bpermute((lane ^ o) << 2, __builtin_bit_cast(int, v)));
    return v;
}

__device__ __forceinline__ void sincos_d(float ang, float& s, float& c) {
    const double x = (double)ang;
    const double n = rint(x * 0.15915494309189535);
    double r = x - n * 6.283185307179586;
    const double k = rint(r * 0.6366197723675814);
    const double t = r - k * 1.5707963267948966;
    const double t2 = t * t;
    double sp = -7.6471637318198164e-13;
    sp = sp * t2 + 1.6059043836821613e-10; sp = sp * t2 - 2.5052108385441720e-08; sp = sp * t2 + 2.7557319223985893e-06;
    sp = sp * t2 - 1.9841269841269841e-04; sp = sp * t2 + 8.3333333333333332e-03; sp = sp * t2 - 1.6666666666666666e-01;
    const double st = t + t * t2 * sp;
    double cp = 4.7794773323873853e-14;
    cp = cp * t2 - 1.1470745597729725e-11; cp = cp * t2 + 2.0876756987868100e-09; cp = cp * t2 - 2.7557319223985888e-07;
    cp = cp * t2 + 2.4801587301587302e-05; cp = cp * t2 - 1.3888888888888889e-03; cp = cp * t2 + 4.1666666666666664e-02; cp = cp * t2 - 0.5;
    const double ct = 1.0 + t2 * cp;
    const int ki = ((int)k) & 3;
    double so, co;
    if (ki == 0) { so = st; co = ct; } else if (ki == 1) { so = ct; co = -st; } else if (ki == 2) { so = -st; co = -ct; } else { so = -ct; co = st; }
    s = (float)so; c = (float)co;
}
__constant__ float c_inv_freq[16] = {1.000000000e+00f, 4.403665960e-01f, 1.939227432e-01f, 8.539710194e-02f, 3.760603070e-02f, 1.656043902e-02f, 7.292664610e-03f, 3.211445874e-03f,
                                     1.414213562e-03f, 6.227723788e-04f, 2.742481884e-04f, 1.207697351e-04f, 5.318296098e-05f, 2.341999971e-05f, 1.031338616e-05f, 4.541670478e-06f};

struct ConvJob { const float* src; bf16* dst; const float* gain; int K, N, ldd, mode, aux; };
struct ConvRegs { f32x4 v[16]; };
__device__ __forceinline__ void conv_load(const ConvJob& J, int item, int lane, ConvRegs& R) {
    const int nblk = J.N >> 6, kb = item / nblk, nb = item - kb * nblk, k0 = kb << 6, n0 = nb << 6;
    const int q = lane >> 4, l = lane & 15;
    const float* sp = J.src + (size_t)(k0 + 16 * q) * J.N + n0 + 4 * l;
#pragma unroll
    for (int r = 0; r < 16; ++r) R.v[r] = __builtin_nontemporal_load((const f32x4*)(sp + (size_t)r * J.N));
}
__device__ __forceinline__ void conv_finish(const ConvJob& J, int item, LAS unsigned* scr, int lane, ConvRegs& R) {
    const int nblk = J.N >> 6, kb = item / nblk, nb = item - kb * nblk, k0 = kb << 6, n0 = nb << 6;
    const int q = lane >> 4, l = lane & 15;
    if (J.gain) { const f32x4* gp = (const f32x4*)(J.gain + k0 + 16 * q);
#pragma unroll
        for (int r4 = 0; r4 < 4; ++r4) { const f32x4 g = gp[r4];
#pragma unroll
            for (int rr = 0; rr < 4; ++rr) R.v[4 * r4 + rr] *= g[rr]; } }
    LAS unsigned char* sb = (LAS unsigned char*)scr;
#pragma unroll
    for (int j = 0; j < 4; ++j) { const int n = 4 * l + j;
#pragma unroll
        for (int c = 0; c < 2; ++c) { v4u w;
#pragma unroll
            for (int e = 0; e < 4; ++e) w[e] = pk2(R.v[8 * c + 2 * e][j], R.v[8 * c + 2 * e + 1][j]);
            *(LAS v4u*)(sb + n * 128 + (((2 * q + c) ^ (l & 7)) << 4)) = w; } }
    LDS_WAIT(); asm volatile("" ::: "memory");
    const int c = lane & 7;
#pragma unroll
    for (int j = 0; j < 8; ++j) { const int n = (lane >> 3) + 8 * j;
        const v4u o = *(const LAS v4u*)(sb + n * 128 + ((c ^ ((n >> 2) & 7)) << 4));
        size_t drow, dcol;
        if (J.mode == 0) { drow = (size_t)(n0 + n); dcol = (size_t)k0 + 8 * c; }
        else { const int d = n0 + n, nbk = k0 >> 8; drow = (size_t)(((J.aux >> 1) * 16 + nbk) * 2 + (d >> 7)) * 256 + (J.aux & 1) * 128 + (d & 127); dcol = (size_t)(k0 & 255) + 8 * c; }
        __builtin_nontemporal_store(o, (GAS v4u*)(J.dst + drow * J.ldd + dcol)); }
    LDS_WAIT(); asm volatile("" ::: "memory");
}

template <bool OUT_F32>
__device__ __forceinline__ void rms_row(const float* xrow, const float* g, void* orow, int lane) {
    const GAS f32x4* xr = (const GAS f32x4*)xrow + lane; const GAS f32x4* gr = (const GAS f32x4*)g + lane;
    f32x4 v[16]; float s = 0.f;
#pragma unroll
    for (int j = 0; j < 16; ++j) { v[j] = xr[64 * j]; s += (v[j].x * v[j].x + v[j].y * v[j].y) + (v[j].z * v[j].z + v[j].w * v[j].w); }
    const float r = __builtin_amdgcn_rsqf(wave_sum(s, lane) * (1.f / DM) + EPS);
#pragma unroll
    for (int j = 0; j < 16; ++j) { const f32x4 gg = gr[64 * j]; const f32x4 o = v[j] * r * gg;
        if (OUT_F32) ((GAS f32x4*)orow + lane)[64 * j] = o;
        else { v2u w; w.x = pk2(o.x, o.y); w.y = pk2(o.z, o.w); ((GAS v2u*)orow + lane)[64 * j] = w; } }
}
__device__ __forceinline__ void rms_row_bf16_in(const bf16* xrow, const float* g, float* orow, int lane) {
    const GAS v4u* xr = (const GAS v4u*)xrow + lane; const GAS f32x4* gr = (const GAS f32x4*)g + 2 * lane;
    v4u w[8]; float s = 0.f;
#pragma unroll
    for (int j = 0; j < 8; ++j) { w[j] = xr[64 * j];
#pragma unroll
        for (int q = 0; q < 4; ++q) { const float a = bf_lo(w[j][q]), b = bf_hi(w[j][q]); s += a * a + b * b; } }
    const float r = __builtin_amdgcn_rsqf(wave_sum(s, lane) * (1.f / DM) + EPS);
#pragma unroll
    for (int j = 0; j < 8; ++j) { const f32x4 g0 = gr[128 * j], g1 = gr[128 * j + 1];
        const f32x4 o0 = (f32x4){bf_lo(w[j].x), bf_hi(w[j].x), bf_lo(w[j].y), bf_hi(w[j].y)} * r * g0, o1 = (f32x4){bf_lo(w[j].z), bf_hi(w[j].z), bf_lo(w[j].w), bf_hi(w[j].w)} * r * g1;
        GAS f32x4* op = (GAS f32x4*)orow + 2 * lane + 128 * j; op[0] = o0; op[1] = o1; }
}
template <bool OUT_F32>
__device__ __forceinline__ void rms_phase(const Frame& F, const float* src, const float* g, void* dst, int rows) {
    for (int m = F.gw; m < rows; m += F.NGW) rms_row<OUT_F32>(src + (size_t)m * DM, g, OUT_F32 ? (void*)((float*)dst + (size_t)m * DM) : (void*)((bf16*)dst + (size_t)m * DM), F.lane);
}
constexpr int CW_ROWSS = 131072;
struct Args { const float* in[35]; float* out; unsigned char* ws; int ph_lo, ph_hi; };
#define KAS __attribute__((address_space(4)))
__device__ __forceinline__ const float* arg_in(int k) { int o = k * 8; asm volatile("" : "+s"(o)); return *(const float* const KAS*)((const KAS char*)__builtin_amdgcn_kernarg_segment_ptr() + o); }
__device__ __forceinline__ float* arg_out() { int o = 280; asm volatile("" : "+s"(o)); return *(float* const KAS*)((const KAS char*)__builtin_amdgcn_kernarg_segment_ptr() + o); }
__device__ __forceinline__ unsigned char* arg_ws() { int o = 288; asm volatile("" : "+s"(o)); return *(unsigned char* const KAS*)((const KAS char*)__builtin_amdgcn_kernarg_segment_ptr() + o); }
static_assert(offsetof(Args, out) == 280 && offsetof(Args, ws) == 288, "Args layout");

__device__ __forceinline__ bool p0_job(unsigned char* ws, int it, ConvJob& J, int& local) {
#define JOB(cnt, SRC, DST, KK, NN, LDD, MODE, AUX, GAIN) if (it < (cnt)) { J.src = (SRC); J.dst = (bf16*)(DST); J.gain = (GAIN); J.K = (KK); J.N = (NN); J.ldd = (LDD); J.mode = (MODE); J.aux = (AUX); local = it; return true; } it -= (cnt);
    JOB(12288, arg_in(4), ws + WS_WQKV, 4096, 12288, 4096, 0, 0, nullptr)
    JOB(1024, arg_in(29), ws + WS_WXKV, 4096, 1024, 4096, 0, 0, nullptr)
    JOB(1024, arg_in(29) + (size_t)4096 * 1024, ws + WS_WXKV + 8 * MiB, 4096, 1024, 4096, 0, 0, nullptr)
    JOB(4096, arg_in(10), ws + WS_WO, 4096, 4096, 4096, 0, 0, nullptr)
    JOB(8192, arg_in(12), ws + WS_WIN, 4096, 8192, 4096, 0, 0, arg_in(11))
    JOB(4096, arg_in(25), ws + WS_WOUT, 4096, 4096, 4096, 0, 0, nullptr)
    JOB(512, arg_in(28), ws + WS_WXQ, 4096, 512, 4096, 0, 0, arg_in(26))
    JOB(512, arg_in(28) + (size_t)4096 * 512, ws + WS_WXQ + 4 * MiB, 4096, 512, 4096, 0, 0, arg_in(26) + DM)
    JOB(512, arg_in(30), ws + WS_WXO, 512, 4096, 512, 0, 0, nullptr)
    JOB(512, arg_in(30) + (size_t)512 * 4096, ws + WS_WXO + 4 * MiB, 512, 4096, 512, 0, 0, nullptr)
    JOB(16384, arg_in(32), ws + WS_W1, 4096, 16384, 4096, 0, 0, arg_in(31))
    JOB(16384, arg_in(32) + (size_t)4096 * 16384, ws + WS_W1 + 128 * MiB, 4096, 16384, 4096, 0, 0, arg_in(31) + DM)
    JOB(16384, arg_in(33), ws + WS_W2, 16384, 4096, 16384, 0, 0, nullptr)
    JOB(16384, arg_in(33) + (size_t)16384 * 4096, ws + WS_W2 + 128 * MiB, 16384, 4096, 16384, 0, 0, nullptr)
    JOB(256, arg_in(15), ws + WS_WG, 4096, 256, 256, 1, 0, nullptr)
    JOB(256, arg_in(17), ws + WS_WG, 4096, 256, 256, 1, 1, nullptr)
    JOB(256, arg_in(20), ws + WS_WG, 4096, 256, 256, 1, 2, nullptr)
    JOB(256, arg_in(22), ws + WS_WG, 4096, 256, 256, 1, 3, nullptr)
#undef JOB
    return false;
}
constexpr int P0_NITEMS = 12288 + 4096 + 8192 + 4096 + 1024 + 2048 + 1024 + 32768 + 32768 + 1024;

__device__ __forceinline__ void p0_convert(const Frame& F, int it_lo, int it_hi, int gw, int ngw) {
    unsigned char* ws = arg_ws();
    LAS unsigned* scr = (LAS unsigned*)(F.lds + F.wave * 8192);
    for (int it = it_lo + gw; it < it_hi; it += 2 * ngw) {
        ConvJob J0, J1; int l0, l1; ConvRegs R0, R1;
        const int it1 = it + ngw; const bool h1 = it1 < it_hi;
        (void)p0_job(ws, it, J0, l0); (void)p0_job(ws, h1 ? it1 : it, J1, l1);
        conv_load(J0, l0, F.lane, R0);
        conv_load(J1, l1, F.lane, R1);
        conv_finish(J0, l0, scr, F.lane, R0);
        if (h1) conv_finish(J1, l1, scr, F.lane, R1);
    }
}
#ifndef QKV_NG
#define QKV_NG 192
#endif
#ifndef P0_FIRST
#define P0_FIRST 14336
#endif
constexpr int P0_FIRST_ITEMS = (QKV_NG < 256) ? P0_FIRST : P0_NITEMS;
__device__ __forceinline__ void p0_prologue(const Frame& F) {
    unsigned char* ws = arg_ws();
    p0_convert(F, 0, P0_FIRST_ITEMS, F.gw, F.NGW);
    { float* ct = (float*)(ws + WS_ROPE); float* st = ct + (size_t)M * 16; const int* pos = (const int*)arg_in(2);
      for (int e = F.gw * 64 + F.lane; e < M * 16; e += F.NGW * 64) { const int row = e >> 4, i = e & 15; float s, c; sincos_d((float)pos[row] * c_inv_freq[i], s, c); ct[e] = c; st[e] = s; } }
    { float* sp8 = (float*)(ws + WS_SP8);
      for (int e = F.gw * 64 + F.lane; e < 2 * DM; e += F.NGW * 64) { const float lam = (e < DM) ? arg_in(19)[e] : arg_in(24)[e - DM]; sp8[e] = 8.f * log1pf(expf(-lam)); } }
    rms_phase<false>(F, arg_in(0), arg_in(3), ws + WS_XN, M);
    rms_phase<false>(F, arg_in(1), arg_in(27), ws + WS_MEMN, NB * MEMT);
    rms_phase<false>(F, arg_in(1), arg_in(27) + DM, ws + WS_MEMN + 4 * MiB, NB * MEMT);
}

__device__ __forceinline__ void conv_phase(const Frame& F) {
    unsigned char* ws = arg_ws();
    const bf16* ug = (const bf16*)(ws + WS_QKV); bf16* uc = (bf16*)(ws + WS_ON);
    const float* cw = arg_in(13); const float* cb = arg_in(14);
    for (int it = F.gw; it < 8 * (M / 32); it += F.NGW) {
        const int g = it & 7, rc = it >> 3, c0 = g * 512 + 8 * F.lane, row0 = rc * 32, t0 = row0 & (SEQ - 1);
        float w[4][8], bb[8];
#pragma unroll
        for (int tap = 0; tap < 4; ++tap) { const f32x4 x0 = *(const f32x4*)(cw + tap * DM + c0), x1 = *(const f32x4*)(cw + tap * DM + c0 + 4);
            w[tap][0] = x0.x; w[tap][1] = x0.y; w[tap][2] = x0.z; w[tap][3] = x0.w; w[tap][4] = x1.x; w[tap][5] = x1.y; w[tap][6] = x1.z; w[tap][7] = x1.w; }
        { const f32x4 x0 = *(const f32x4*)(cb + c0), x1 = *(const f32x4*)(cb + c0 + 4); bb[0] = x0.x; bb[1] = x0.y; bb[2] = x0.z; bb[3] = x0.w; bb[4] = x1.x; bb[5] = x1.y; bb[6] = x1.z; bb[7] = x1.w; }
        v4u raw[35];
#pragma unroll
        for (int i = 0; i < 35; ++i) { const int t = t0 + i - 2; const bool ok = (t >= 0 && t < SEQ); const int rr = ok ? row0 + i - 2 : row0;
            const v4u x = *(const GAS v4u*)(ug + (size_t)rr * (2 * DM) + c0); const unsigned msk = ok ? 0xffffffffu : 0u; raw[i] = (v4u){x.x & msk, x.y & msk, x.z & msk, x.w & msk}; }
#pragma unroll
        for (int i = 0; i < 32; ++i) { float o[8];
#pragma unroll
            for (int j = 0; j < 8; ++j) o[j] = bb[j];
#pragma unroll
            for (int tap = 0; tap < 4; ++tap) { const v4u r = raw[i + tap];
#pragma unroll
                for (int q = 0; q < 4; ++q) { o[2 * q] = fmaf(bf_lo(r[q]), w[tap][2 * q], o[2 * q]); o[2 * q + 1] = fmaf(bf_hi(r[q]), w[tap][2 * q + 1], o[2 * q + 1]); } }
            v4u ov; ov.x = pk2(o[0], o[1]); ov.y = pk2(o[2], o[3]); ov.z = pk2(o[4], o[5]); ov.w = pk2(o[6], o[7]);
            *(GAS v4u*)(uc + (size_t)(row0 + i) * DM + c0) = ov; }
    }
}

constexpr float L2E = 1.4426950408889634f;
__device__ __forceinline__ void scan_agg_phase(const Frame& F) {
    unsigned char* ws = arg_ws();
    const unsigned* G = (const unsigned*)(ws + WS_R256); float* aggA = (float*)(ws + WS_AGG); float* aggH = aggA + (size_t)2 * 2 * 64 * DM;
    for (int it = F.gw; it < 4096; it += F.NGW) {
        const int cg = it & 15, k = (it >> 4) & 63, b = (it >> 10) & 1, dir = it >> 11, ch = cg * 256 + 4 * F.lane;
        const unsigned* gp = G + (size_t)dir * ((size_t)M * DM) + (size_t)(b * SEQ + k * 64) * DM + ch;
        f32x4 sla = {0.f, 0.f, 0.f, 0.f}, H = {0.f, 0.f, 0.f, 0.f};
#pragma unroll 16
        for (int s = 0; s < 64; ++s) { const int t = dir ? 63 - s : s; const v4u w = *(const GAS v4u*)(gp + (size_t)t * DM);
#pragma unroll
            for (int j = 0; j < 4; ++j) { const float la = bf_lo(w[j]), inp = bf_hi(w[j]); H[j] = fmaf(__builtin_amdgcn_exp2f(la * L2E), H[j], inp); sla[j] += la; } }
        const size_t o = (size_t)((dir * 2 + b) * 64 + k) * DM + ch;
        *(GAS f32x4*)(aggA + o) = sla; *(GAS f32x4*)(aggH + o) = H;
    }
}
__device__ __forceinline__ void scan_carry_phase(const Frame& F) {
    unsigned char* ws = arg_ws();
    const float* aggA = (const float*)(ws + WS_AGG); const float* aggH = aggA + (size_t)2 * 2 * 64 * DM; float* carry = (float*)(ws + WS_CARRY);
    const int task = (int)blockIdx.x;
    if (task < 64 && F.wave == 0) {
        const int cg = task & 15, b = (task >> 4) & 1, dir = task >> 5, ch = cg * 256 + 4 * F.lane;
        f32x4 c = {0.f, 0.f, 0.f, 0.f};
#pragma unroll 16
        for (int s = 0; s < 64; ++s) { const int k = dir ? 63 - s : s; const size_t o = (size_t)((dir * 2 + b) * 64 + k) * DM + ch;
            const f32x4 A = *(const GAS f32x4*)(aggA + o), H = *(const GAS f32x4*)(aggH + o);
            *(GAS f32x4*)(carry + o) = c;
#pragma unroll
            for (int j = 0; j < 4; ++j) c[j] = fmaf(__builtin_amdgcn_exp2f(A[j] * L2E), c[j], H[j]); }
    }
}
__device__ __forceinline__ float gelu_tanh_f(float g) { const float u = 0.7978845608028654f * (g + 0.044715f * g * g * g); return g * __builtin_amdgcn_rcpf(1.f + __builtin_amdgcn_exp2f(-2.f * L2E * u)); }
__device__ __forceinline__ void scan_final_phase(const Frame& F) {
    unsigned char* ws = arg_ws();
    const unsigned* G = (const unsigned*)(ws + WS_R256); const float* carry = (const float*)(ws + WS_CARRY);
    const bf16* ug = (const bf16*)(ws + WS_QKV); bf16* Y = (bf16*)(ws + WS_Y);
    for (int it = F.gw; it < 2048; it += F.NGW) {
        const int cg = it & 15, k = (it >> 4) & 63, b = it >> 10, ch = cg * 256 + 4 * F.lane;
        const size_t rowbase = (size_t)(b * SEQ + k * 64);
        const unsigned* gf = G + rowbase * DM + ch; const unsigned* gb = gf + (size_t)M * DM;
        f32x4 h = *(const GAS f32x4*)(carry + (size_t)((0 * 2 + b) * 64 + k) * DM + ch);
        v2u hf[64];
#pragma unroll
        for (int tb = 0; tb < 64; tb += 16) { v4u w[16];
#pragma unroll
            for (int t = 0; t < 16; ++t) w[t] = *(const GAS v4u*)(gf + (size_t)(tb + t) * DM);
#pragma unroll
            for (int t = 0; t < 16; ++t) {
#pragma unroll
                for (int j = 0; j < 4; ++j) h[j] = fmaf(__builtin_amdgcn_exp2f(bf_lo(w[t][j]) * L2E), h[j], bf_hi(w[t][j]));
                hf[tb + t].x = pk2(h[0], h[1]); hf[tb + t].y = pk2(h[2], h[3]); }
            asm volatile("" ::: "memory"); }
        h = *(const GAS f32x4*)(carry + (size_t)((1 * 2 + b) * 64 + k) * DM + ch);
#pragma unroll
        for (int tb = 48; tb >= 0; tb -= 16) { v4u w[16]; v2u gw2[16];
#pragma unroll
            for (int t = 15; t >= 0; --t) { w[t] = *(const GAS v4u*)(gb + (size_t)(tb + t) * DM); gw2[t] = *(const GAS v2u*)(ug + (rowbase + tb + t) * (2 * DM) + DM + ch); }
#pragma unroll
            for (int t = 15; t >= 0; --t) {
#pragma unroll
                for (int j = 0; j < 4; ++j) h[j] = fmaf(__builtin_amdgcn_exp2f(bf_lo(w[t][j]) * L2E), h[j], bf_hi(w[t][j]));
                const v2u f = hf[tb + t];
                const float y0 = (bf_lo(f.x) + h[0]) * gelu_tanh_f(bf_lo(gw2[t].x)), y1 = (bf_hi(f.x) + h[1]) * gelu_tanh_f(bf_hi(gw2[t].x));
                const float y2 = (bf_lo(f.y) + h[2]) * gelu_tanh_f(bf_lo(gw2[t].y)), y3 = (bf_hi(f.y) + h[3]) * gelu_tanh_f(bf_hi(gw2[t].y));
                v2u o; o.x = pk2(y0, y1); o.y = pk2(y2, y3); *(GAS v2u*)(Y + (rowbase + tb + t) * DM + ch) = o; }
            asm volatile("" ::: "memory"); }
    }
}

struct SchedX1 {
    const char* xn; const char* wq; const char* memn; const char* wkv; int c; int mode;
    __device__ __forceinline__ bool next(int i, pg8::Unit& u) const {
        if (mode == 2) { if (c >= 16 || i > 0) return false; const int layer = c >> 3, pm = (c >> 2) & 1, pn = c & 3;
            u.A = memn + (size_t)layer * (4 * MiB) + (size_t)pm * 256 * 8192; u.B = wkv + (size_t)layer * (8 * MiB) + (size_t)pn * 256 * 8192; u.nt = 64; u.job = 1; u.aux = layer; u.pm = pm; u.pn = pn; return true; }
        const int q = c + i * 256;
        if (q >= 256) return false;
        const int ks = q & 3, pn = (q >> 2) & 1, pm = q >> 3;
        u.A = xn + (size_t)pm * 256 * 8192 + ks * 2048; u.B = wq + (size_t)pn * 256 * 8192 + ks * 2048; u.nt = 16; u.job = 0; u.aux = ks; u.pm = pm; u.pn = pn; return true;
    }
};
struct SchedGates {
    const char* uc; const char* wg; int vcu;
    __device__ __forceinline__ bool next(int i, pg8::Unit& u) const {
        const int L = i * 256 + vcu; if (L >= 2048) return false;
        const int half = L & 1, dir = (L >> 1) & 1, nb = (L >> 2) & 15, pm = L >> 6;
        u.A = uc + (size_t)pm * 256 * 8192 + nb * 512; u.B = wg + (size_t)(((dir * 16 + nb) * 2 + half) * 256) * 512; u.nt = 4; u.job = 0; u.aux = dir * 32 + nb * 2 + half; u.pm = pm; u.pn = 0; return true;
    }
};

#ifndef ATT_KS_BODY
#define ATT_KS_BODY attn_ks1_body
#endif
#ifndef ATT_SDEPTH
#define ATT_SDEPTH 1
#endif
__device__ __forceinline__ bool ph_in(int ph, int lo, int hi) { asm volatile("" : "+s"(ph)); return ph >= lo && ph < hi; }
__global__ void __launch_bounds__(NWAVES * 64, 2) mega_fwd(Args args) {
    extern __shared__ __attribute__((aligned(16))) unsigned char lds[];
    Frame F0;
    F0.lds = (LAS unsigned char*)lds;
    F0.tid = threadIdx.x; F0.lane = F0.tid & 63; F0.wave = __builtin_amdgcn_readfirstlane(F0.tid >> 6);
    F0.G = gridDim.x; { const int bx = blockIdx.x; F0.vcu = (F0.G % 8 == 0) ? (bx % 8) * (F0.G / 8) + bx / 8 : bx; }
    F0.gw = F0.vcu * NWAVES + F0.wave; F0.NGW = F0.G * NWAVES;
    volatile LAS unsigned* MISC = (volatile LAS unsigned*)(F0.lds + MISC_OFF);
    for (int u = F0.tid; u < (LDS_BYTES - LDSCTL_OFF) / 4; u += NWAVES * 64) ((LAS unsigned*)(F0.lds + LDSCTL_OFF))[u] = 0u;
    __syncthreads();
    const int lo = args.ph_lo, hi = args.ph_hi;
    XcdBarrier bar; bar.bar = (unsigned*)(args.ws + WS_CTL) + CW_BAR; bar.x = 0; bar.st = nullptr;
    if (hi - lo > 1) bar = xcd_barrier_post((unsigned*)(args.ws + WS_CTL) + CW_BAR, MISC + 8);
    int ph = 0;
#ifndef MK_PHMASK
#define MK_PHMASK 0xffffffffull
#endif
#ifndef MK_REPEAT
#define MK_REPEAT 0ull
#endif
#define PH_BEGIN(ID) if (((MK_PHMASK >> (ID)) & 1ull) != 0ull && ph_in(ph, lo, hi)) { unsigned char* ws = arg_ws(); pg8::bf16_t* h = (pg8::bf16_t*)(ws + WS_H); const char* xn = (const char*)(ws + WS_XN); const char* hA = (const char*)(ws + WS_H); (void)h; (void)xn; (void)hA; Frame F = F0; F.lane = pg8::lane_now(); F.tid = F.wave * 64 + F.lane; asm volatile("" : "+v"(F.lane), "+v"(F.tid), "+s"(F.gw), "+s"(F.vcu)); (void)F; constexpr int NREP = 1 + (int)((MK_REPEAT >> (ID)) & 1ull); for (int rep = 0; rep < NREP; ++rep) { const bool dummy = (rep + 1 < NREP); pg8::bf16_t* hout = dummy ? (pg8::bf16_t*)(ws + WS_QKV) : h; (void)hout; unsigned long long* RS = (unsigned long long*)((unsigned*)(ws + WS_CTL) + CW_ROWSS); (void)RS; unsigned long long* RSn = dummy ? nullptr : RS; (void)RSn;
#define PH_END   if (rep + 1 < NREP) xcd_barrier(bar, F0.wave); } if (ph + 1 < hi) xcd_barrier(bar, F0.wave); } ++ph;


    PH_BEGIN(0) p0_prologue(F); PH_END

    for (int layer = 0; layer < 2; ++layer) {
        if (layer == 0) {
            PH_BEGIN(1) if (QKV_NG < 256 && (int)blockIdx.x >= QKV_NG) {
                {
                    SchedX1 S{nullptr, nullptr, (const char*)(ws + WS_MEMN), (const char*)(ws + WS_WXKV), (int)blockIdx.x - QKV_NG, 2};
                    pg8::EpiX1 E{nullptr, (pg8::bf16_t*)(ws + WS_KV), (pg8::bf16_t*)(ws + WS_KV + 1 * MiB), nullptr};
                    pg8::gemm_phase<pg8::EpiX1, SchedX1, true>(F.lds, 8192u, 8192u, S, E, F.wave); }
                p0_convert(F, P0_FIRST_ITEMS, P0_NITEMS, ((int)blockIdx.x - QKV_NG) * NWAVES + F.wave, (256 - QKV_NG) * NWAVES); } else {
                pg8::SchedPlain S; S.A = xn; S.B = (const char*)(ws + WS_WQKV); S.lda = 8192; S.ldb = 8192; S.nt = 64; S.so.init(M, 3 * DM, QKV_NG < 256 ? QKV_NG : F.G, (int)blockIdx.x);
                pg8::EpiQKV E{(pg8::bf16_t*)(ws + WS_QKV), (size_t)M * DM, (const float*)(ws + WS_ROPE), (const float*)(ws + WS_ROPE) + (size_t)M * 16};
                pg8::gemm_phase<pg8::EpiQKV, pg8::SchedPlain, true>(F.lds, 8192u, 8192u, S, E, F.wave);
            } PH_END
            PH_BEGIN(2) {
                const bf16* Q = (const bf16*)(ws + WS_QKV); const bf16* K = Q + (size_t)M * DM; const bf16* V = K + (size_t)M * DM; bf16* On = (bf16*)(ws + WS_ON);
                static_assert(att::KS_BYTES <= RING_BYTES, "attention LDS");
                float lam;
                { const int l = F.lane; float s1 = arg_in(5)[l] * arg_in(6)[l] + arg_in(5)[l + 64] * arg_in(6)[l + 64], s2 = arg_in(7)[l] * arg_in(8)[l] + arg_in(7)[l + 64] * arg_in(8)[l + 64];
                  s1 = wave_sum(s1, l); s2 = wave_sum(s2, l); lam = expf(s1) - expf(s2) + LAM_INIT0; }
                const float* subg = arg_in(9);
                for (int i = 0; i < 4; ++i) {
                    const int x = F.vcu >> 5, qb = F.vcu & 31, bh = i * 8 + x, hh = bh & 15, b = bh >> 4;
                    const size_t hoff = (size_t)(b * 16 + hh) * 2 * SEQ * 128, qoff = hoff + (size_t)(qb * 128) * 128, ooff = (size_t)(b * SEQ + qb * 128) * DM + hh * 256;
                    unsigned o0p[4][8];
                    att::ATT_KS_BODY<128, 128, DM, 0, SEQ * 128 * 2>(Q + qoff, K + hoff, V + hoff, nullptr, SEQ, (char*)lds, F.wave, o0p, lam, subg, 1.f - LAM_INIT0);
                    att::ATT_KS_BODY<128, 128, DM, 1, SEQ * 128 * 2>(Q + qoff + (size_t)SEQ * 128, K + hoff + (size_t)SEQ * 128, V + hoff, On + ooff, SEQ, (char*)lds, F.wave, o0p, lam, subg, 1.f - LAM_INIT0);
                }
            } PH_END
            PH_BEGIN(4) {
                pg8::SchedPlain S; S.A = (const char*)(ws + WS_ON); S.B = (const char*)(ws + WS_WO); S.lda = 8192; S.ldb = 8192; S.nt = 64; S.so.init(M, DM, F.G, (int)blockIdx.x);
                pg8::EpiRes<DM, true> E{arg_in(0), h, RSn ? RSn + 0 * M : nullptr};
                pg8::gemm_phase<pg8::EpiRes<DM, true>, pg8::SchedPlain, true>(F.lds, 8192u, 8192u, S, E, F.wave);
            } PH_END
        } else {
            PH_BEGIN(6) {
                pg8::SchedPlain S; S.A = hA; S.B = (const char*)(ws + WS_WIN); S.lda = 8192; S.ldb = 8192; S.nt = 64; S.so.init(M, 2 * DM, F.G, (int)blockIdx.x);
                pg8::EpiBf16<0, 2 * DM> E{(pg8::bf16_t*)(ws + WS_QKV), RS + 2 * M};
                pg8::gemm_phase<pg8::EpiBf16<0, 2 * DM>, pg8::SchedPlain, true>(F.lds, 8192u, 8192u, S, E, F.wave);
            } PH_END
            PH_BEGIN(7) conv_phase(F); PH_END
            PH_BEGIN(8) {
                SchedGates S{(const char*)(ws + WS_ON), (const char*)(ws + WS_WG), F.vcu};
                pg8::EpiGates E; E.uc = (const pg8::bf16_t*)(ws + WS_ON); E.ba[0] = arg_in(16); E.ba[1] = arg_in(21); E.bi[0] = arg_in(18); E.bi[1] = arg_in(23);
                E.sp8[0] = (const float*)(ws + WS_SP8); E.sp8[1] = (const float*)(ws + WS_SP8) + DM; E.G = (unsigned*)(ws + WS_R256);
                pg8::gemm_phase<pg8::EpiGates, SchedGates, true>(F.lds, 8192u, 512u, S, E, F.wave);
            } PH_END
            PH_BEGIN(9) scan_agg_phase(F); PH_END
            PH_BEGIN(10) scan_carry_phase(F); PH_END
            PH_BEGIN(11) scan_final_phase(F); PH_END
            PH_BEGIN(12) {
                pg8::SchedPlain S; S.A = (const char*)(ws + WS_Y); S.B = (const char*)(ws + WS_WOUT); S.lda = 8192; S.ldb = 8192; S.nt = 64; S.so.init(M, DM, F.G, (int)blockIdx.x);
                pg8::EpiRes<DM, false> E{h, hout, RSn ? RSn + 3 * M : nullptr};
                pg8::gemm_phase<pg8::EpiRes<DM, false>, pg8::SchedPlain, true>(F.lds, 8192u, 8192u, S, E, F.wave);
            } PH_END
        }
        PH_BEGIN(14) {
            SchedX1 S{hA, (const char*)(ws + WS_WXQ + (size_t)layer * 4 * MiB), (const char*)(ws + WS_MEMN), (const char*)(ws + WS_WXKV), (int)blockIdx.x, 0};
            pg8::EpiX1 E{(float*)(ws + WS_SLAB), (pg8::bf16_t*)(ws + WS_KV), (pg8::bf16_t*)(ws + WS_KV + 1 * MiB), RS + (3 * layer) * M};
            pg8::gemm_phase<pg8::EpiX1, SchedX1, true>(F.lds, 8192u, 8192u, S, E, F.wave);
        } PH_END
        PH_BEGIN(15) {
            const int u = (int)blockIdx.x;
            if (u < 128) { const int b = u >> 6, hh = (u >> 4) & 3, qb = u & 15;
                const float* Qs = (const float*)(ws + WS_SLAB) + (size_t)(b * SEQ + qb * 256) * XW + hh * 128;
                const bf16* Kh = (const bf16*)(ws + WS_KV + (size_t)layer * MiB) + (size_t)(b * MEMT) * 1024 + hh * 128;
                bf16* Ob = (bf16*)(ws + WS_OX) + (size_t)(b * SEQ + qb * 256) * XW + hh * 128;
                int seqv = MEMT; asm volatile("" : "+s"(seqv));
                att::attn_dense_body<1, 1, XW, 1024, XW, ATT_SDEPTH>(Qs, (size_t)M * XW, Kh, Kh + XW, Ob, seqv, (char*)lds, F.wave); }
        } PH_END
        PH_BEGIN(16) {
            pg8::SchedPlain S; S.A = (const char*)(ws + WS_OX); S.B = (const char*)(ws + WS_WXO + (size_t)layer * 4 * MiB); S.lda = 1024; S.ldb = 1024; S.nt = 8; S.so.init(M, DM, F.G, (int)blockIdx.x);
            pg8::EpiRes<DM, false> E{h, hout, RSn ? RSn + (1 + 3 * layer) * M : nullptr};
            pg8::gemm_phase<pg8::EpiRes<DM, false>, pg8::SchedPlain, true>(F.lds, 1024u, 1024u, S, E, F.wave);
        } PH_END
        PH_BEGIN(18) {
            pg8::SchedPlain S; S.A = hA; S.B = (const char*)(ws + WS_W1 + (size_t)layer * 128 * MiB); S.lda = 8192; S.ldb = 8192; S.nt = 64; S.so.init(M, DFF, F.G, (int)blockIdx.x);
            pg8::EpiBf16<2, DFF> E{(pg8::bf16_t*)(ws + WS_R256), RS + (1 + 3 * layer) * M};
            pg8::gemm_phase<pg8::EpiBf16<2, DFF>, pg8::SchedPlain, true>(F.lds, 8192u, 8192u, S, E, F.wave);
        } PH_END
        PH_BEGIN(19) {
            pg8::SchedPlain S; S.A = (const char*)(ws + WS_R256); S.B = (const char*)(ws + WS_W2 + (size_t)layer * 128 * MiB); S.lda = 32768; S.ldb = 32768; S.nt = 256; S.so.init(M, DM, F.G, (int)blockIdx.x);
            pg8::EpiRes<DM, false> E{h, hout, (layer == 0 && RSn) ? RSn + 2 * M : nullptr};
            pg8::gemm_phase<pg8::EpiRes<DM, false>, pg8::SchedPlain, true>(F.lds, 32768u, 32768u, S, E, F.wave);
        } PH_END
    }
    PH_BEGIN(20) { const float* fg = arg_in(34); float* fo = arg_out(); for (int m = F.gw; m < M; m += F.NGW) rms_row_bf16_in((const bf16*)h + (size_t)m * DM, fg, fo + (size_t)m * DM, F.lane); } PH_END
#undef PH_BEGIN
#undef PH_END
}
constexpr int N_PHASES = 22;
#ifndef MK_CHECK
#define MK_CHECK 0
#endif
#ifndef MK_ONE_LAUNCH
#define MK_ONE_LAUNCH 1
#endif
#if MK_CHECK
constexpr int CHK_ROW0 = 3072, CHK_ROWS = 2048;
constexpr int CW_CHK = 65536;
__global__ __launch_bounds__(256) void k_cmp(const float* __restrict__ a, long lda, const void* __restrict__ b, long ldb, int b_bf16, float scale_b, int rows, int cols, float* acc) {
    __shared__ float red[4];
    float e = 0.f, r = 0.f;
    const long n = (long)rows * cols;
    for (long i = (long)blockIdx.x * 256 + threadIdx.x; i < n; i += (long)gridDim.x * 256) {
        const long row = i / cols, col = i % cols;
        const float av = a[row * lda + col];
        float bv = b_bf16 ? __uint_as_float((unsigned)((const unsigned short*)b)[row * ldb + col] << 16) : ((const float*)b)[row * ldb + col];
        bv *= scale_b; const float d = av - bv;
        if (!(d == d)) e += 1e30f; else e += d * d;
        r += av * av;
    }
    e = nv::block_sum_256(e, red); r = nv::block_sum_256(r, red);
    if (threadIdx.x == 0) { atomicAdd(acc, e); atomicAdd(acc + 1, r); }
}
__global__ void k_poison(const float* acc, int nchk, float tol, float* out) {
    if (threadIdx.x == 0 && blockIdx.x == 0) {
        for (int i = 0; i < nchk; ++i) { const float e = acc[2 * i], r = acc[2 * i + 1]; if (!(e <= tol * r)) { out[0] += 1000.f * (float)(i + 1); break; } }
    }
}
#endif

extern "C" void kernel_launch(void* const* d_in, const int* in_sizes, int n_in, void* d_out, int out_size, void* d_ws, size_t ws_size, hipStream_t stream) {
    static int grid = 0;
    if (grid == 0) {
        if (n_in != 35 || out_size != M * DM || ws_size < (size_t)2040 * MiB) { fprintf(stderr, "kernel_launch: unexpected shapes: n_in %d out %d ws %zu\n", n_in, out_size, ws_size); grid = -1; return; }
        int dev = 0, cus = 0, per_cu = 0;
        if (hipGetDevice(&dev) != hipSuccess || hipDeviceGetAttribute(&cus, hipDeviceAttributeMultiprocessorCount, dev) != hipSuccess) { grid = -1; return; }
        if (hipFuncSetAttribute((const void*)mega_fwd, hipFuncAttributeMaxDynamicSharedMemorySize, LDS_BYTES) != hipSuccess) { fprintf(stderr, "kernel_launch: hipFuncSetAttribute failed\n"); grid = -1; return; }
        if (hipOccupancyMaxActiveBlocksPerMultiprocessor(&per_cu, (const void*)mega_fwd, NWAVES * 64, LDS_BYTES) != hipSuccess || per_cu < 1) fprintf(stderr, "kernel_launch: occupancy query reports %d\n", per_cu);
        (void)hipGetLastError();
        grid = cus;
#if MK_CHECK
        (void)hipFuncSetAttribute((const void*)nv::k_diffattn, hipFuncAttributeMaxDynamicSharedMemorySize, nv::AT_SM_FLOATS * 4);
#endif
    }
    if (grid < 0) return;
    (void)hipMemsetAsync((char*)d_ws + WS_CTL, 0, CTL_ZERO_BYTES, stream);
    Args a{};
    for (int i = 0; i < 35; ++i) a.in[i] = (const float*)d_in[i];
    a.out = (float*)d_out; a.ws = (unsigned char*)d_ws;
#if !MK_CHECK
#if MK_ONE_LAUNCH
    a.ph_lo = 0; a.ph_hi = N_PHASES;
    hipLaunchKernelGGL(mega_fwd, dim3(grid), dim3(NWAVES * 64), LDS_BYTES, stream, a);
#else
    for (int p = 0; p < N_PHASES; ++p) { a.ph_lo = p; a.ph_hi = p + 1; hipLaunchKernelGGL(mega_fwd, dim3(grid), dim3(NWAVES * 64), LDS_BYTES, stream, a); }
#endif
#else
    char* ws = (char*)d_ws;
    char* stash = ws + (size_t)1720 * MiB; size_t so = 0;
    auto stash_rows = [&](size_t src_off, size_t row_bytes) { char* p = stash + so; (void)hipMemcpyAsync(p, ws + src_off + (size_t)CHK_ROW0 * row_bytes, (size_t)CHK_ROWS * row_bytes, hipMemcpyDeviceToDevice, stream); so += (size_t)CHK_ROWS * row_bytes; return p; };
    char *sQ = nullptr, *sK = nullptr, *sV = nullptr, *sOn = nullptr, *sH4 = nullptr, *sH8 = nullptr, *sH11 = nullptr, *sUc = nullptr, *sY = nullptr, *sH19 = nullptr, *sH23 = nullptr, *sOut = nullptr;
    for (int p = 0; p < N_PHASES; ++p) {
        a.ph_lo = p; a.ph_hi = p + 1; hipLaunchKernelGGL(mega_fwd, dim3(grid), dim3(NWAVES * 64), LDS_BYTES, stream, a);
        if (p == 1) { sQ = stash_rows(WS_QKV, DM * 2); sK = stash_rows(WS_QKV + 64 * MiB, DM * 2); sV = stash_rows(WS_QKV + 128 * MiB, DM * 2); }
        if (p == 2) sOn = stash_rows(WS_ON, DM * 2);
        if (p == 3) sH4 = stash_rows(WS_H, DM * 2);
        if (p == 6) sH8 = stash_rows(WS_H, DM * 2);
        if (p == 8) sH11 = stash_rows(WS_H, DM * 2);
        if (p == 10) sUc = stash_rows(WS_ON, DM * 2);
        if (p == 14) sY = stash_rows(WS_Y, DM * 2);
        if (p == 15) sH19 = stash_rows(WS_H, DM * 2);
        if (p == 18) sH23 = stash_rows(WS_H, DM * 2);
        if (p == 21) { sOut = stash + so; (void)hipMemcpyAsync(sOut, (char*)d_out + (size_t)CHK_ROW0 * DM * 4, (size_t)CHK_ROWS * DM * 4, hipMemcpyDeviceToDevice, stream); so += (size_t)CHK_ROWS * DM * 4; }
    }
    {
        using namespace nv;
        const size_t Fz = sizeof(float); const size_t SZ_H = (size_t)M * DM * Fz, SZ_BIG = (size_t)M * DFF * Fz;
        size_t off = 1 * MiB;
        auto carve = [&](size_t bytes) { float* p = (float*)(ws + off); off += (bytes + 255) / 256 * 256; return p; };
        float* h = carve(SZ_H); float* xn = carve(SZ_H); float* big = carve(SZ_BIG);
        float* t1 = carve(SZ_H); float* t2 = carve(SZ_H); float* t3 = carve(SZ_H); float* t4 = carve(SZ_H); float* t5 = carve(SZ_H);
        float* memn = carve((size_t)NB * MEMT * DM * Fz); float* kvb = carve((size_t)NB * MEMT * 2 * XW * Fz); float* qx = carve((size_t)M * XW * Fz); float* ox = carve((size_t)M * XW * Fz);
        float* lamd = carve(256);
        if (off > (size_t)1720 * MiB) { fprintf(stderr, "check build: naive buffers overflow\n"); return; }
        float* acc = (float*)ws + CW_CHK; int ci = 0;
        auto cmp = [&](const float* nav, long lda, const char* st, long ldb, int isbf, float sc, int cols) {
            hipLaunchKernelGGL(k_cmp, dim3(1024), dim3(256), 0, stream, nav + (size_t)CHK_ROW0 * lda, lda, (const void*)st, ldb, isbf, sc, CHK_ROWS, cols, acc + 2 * ci); ++ci; };
        auto in = [&](int i) { return (const float*)d_in[i]; };
        auto gemm = [&](const float* A, int lda, const float* B, int ldb, float* C, int ldc, int m, int n, int k, int accum, int batch = 1, long sA = 0, long sB = 0, long sC = 0) {
            hipLaunchKernelGGL(k_gemm, dim3(n / 128, m / 128, batch), dim3(256), 0, stream, A, lda, sA, B, ldb, sB, C, ldc, sC, k, accum); };
        const float* x = in(0); const float* mem = in(1); const int* pos = (const int*)d_in[2];
        (void)hipMemcpyAsync(h, x, SZ_H, hipMemcpyDeviceToDevice, stream);
        for (int layer = 0; layer < 2; ++layer) {
            if (layer == 0) {
                hipLaunchKernelGGL(k_rmsnorm, dim3(M), dim3(256), 0, stream, h, in(3), xn, DM, 1.f);
                gemm(xn, DM, in(4), 3 * DM, big, 3 * DM, M, 3 * DM, DM, 0);
                hipLaunchKernelGGL(k_rope, dim3(M), dim3(256), 0, stream, big, pos);
                cmp(big, 3 * DM, sQ, DM, 1, 0.08838834764831845f, DM);
                cmp(big + DM, 3 * DM, sK, DM, 1, 1.f, DM);
                cmp(big + 2 * DM, 3 * DM, sV, DM, 1, 1.f, DM);
                hipLaunchKernelGGL(k_lambda, dim3(1), dim3(64), 0, stream, in(5), in(6), in(7), in(8), 0.2f, lamd);
                hipLaunchKernelGGL(k_diffattn, dim3(SEQ / AT_Q, NH, NB), dim3(256), AT_SM_FLOATS * 4, stream, big, lamd, t1);
                hipLaunchKernelGGL(k_rmsnorm, dim3(M * NH), dim3(256), 0, stream, t1, in(9), t2, VD, 0.8f);
                cmp(t2, DM, sOn, DM, 1, 1.f, DM);
                gemm(t2, DM, in(10), DM, h, DM, M, DM, DM, 1);
                cmp(h, DM, sH4, DM, 1, 1.f, DM);
            } else {
                hipLaunchKernelGGL(k_rmsnorm, dim3(M), dim3(256), 0, stream, h, in(11), xn, DM, 1.f);
                gemm(xn, DM, in(12), 2 * DM, big, 2 * DM, M, 2 * DM, DM, 0);
                hipLaunchKernelGGL(k_conv, dim3(M * DM / 256), dim3(256), 0, stream, big, in(13), in(14), t1);
                cmp(t1, DM, sUc, DM, 1, 1.f, DM);
                gemm(t1, DM, in(15), 256, t2, DM, M, 256, 256, 0, 16, 256, 65536, 256);
                gemm(t1, DM, in(17), 256, t3, DM, M, 256, 256, 0, 16, 256, 65536, 256);
                hipLaunchKernelGGL(k_scan, dim3(NB * DM / 64), dim3(64), 0, stream, t2, t3, t1, in(16), in(18), in(19), t4, 0);
                gemm(t1, DM, in(20), 256, t2, DM, M, 256, 256, 0, 16, 256, 65536, 256);
                gemm(t1, DM, in(22), 256, t3, DM, M, 256, 256, 0, 16, 256, 65536, 256);
                hipLaunchKernelGGL(k_scan, dim3(NB * DM / 64), dim3(64), 0, stream, t2, t3, t1, in(21), in(23), in(24), t4, 1);
                hipLaunchKernelGGL(k_gate, dim3(M * DM / 256), dim3(256), 0, stream, t4, big, t5);
                cmp(t5, DM, sY, DM, 1, 1.f, DM);
                gemm(t5, DM, in(25), DM, h, DM, M, DM, DM, 1);
                cmp(h, DM, sH19, DM, 1, 1.f, DM);
            }
            hipLaunchKernelGGL(k_rmsnorm, dim3(M), dim3(256), 0, stream, h, in(26) + layer * DM, xn, DM, 1.f);
            gemm(xn, DM, in(28) + (size_t)layer * DM * XW, XW, qx, XW, M, XW, DM, 0);
            hipLaunchKernelGGL(k_rmsnorm, dim3(NB * MEMT), dim3(256), 0, stream, mem, in(27) + layer * DM, memn, DM, 1.f);
            gemm(memn, DM, in(29) + (size_t)layer * DM * 2 * XW, 2 * XW, kvb, 2 * XW, NB * MEMT, 2 * XW, DM, 0);
            hipLaunchKernelGGL(k_xattn, dim3(M, XH), dim3(64), 0, stream, qx, kvb, ox);
            gemm(ox, XW, in(30) + (size_t)layer * XW * DM, DM, h, DM, M, DM, XW, 1);
            cmp(h, DM, layer == 0 ? sH8 : sH23, DM, 1, 1.f, DM);
            hipLaunchKernelGGL(k_rmsnorm, dim3(M), dim3(256), 0, stream, h, in(31) + layer * DM, xn, DM, 1.f);
            gemm(xn, DM, in(32) + (size_t)layer * DM * DFF, DFF, big, DFF, M, DFF, DM, 0);
            hipLaunchKernelGGL(k_relu2, dim3((size_t)M * DFF / 256), dim3(256), 0, stream, big);
            gemm(big, DFF, in(33) + (size_t)layer * DFF * DM, DM, h, DM, M, DM, DFF, 1);
            if (layer == 0) cmp(h, DM, sH11, DM, 1, 1.f, DM);
        }
        hipLaunchKernelGGL(k_rmsnorm, dim3(M), dim3(256), 0, stream, h, in(34), (float*)d_out, DM, 1.f);
        cmp((float*)d_out, DM, sOut, DM, 0, 1.f, DM);
        hipLaunchKernelGGL(k_poison, dim3(1), dim3(64), 0, stream, acc, ci, 2e-3f, (float*)d_out);
    }
#endif
}
```

```cpp
#include <hip/hip_runtime.h>
#include <cstdio>
#include <cstdint>
namespace pg8 {
__device__ __forceinline__ int lane_now() { int l; asm volatile("v_mbcnt_lo_u32_b32 %0, -1, 0\n\tv_mbcnt_hi_u32_b32 %0, -1, %0" : "=v"(l)); return l; }
#define PG8_LAS __attribute__((address_space(3)))
typedef unsigned short bf16_t;
typedef short bf16x8 __attribute__((ext_vector_type(8)));
typedef float f32x4 __attribute__((ext_vector_type(4)));
typedef float f32x2 __attribute__((ext_vector_type(2)));
typedef unsigned u32x4 __attribute__((ext_vector_type(4)));
typedef unsigned u32x2 __attribute__((ext_vector_type(2)));
constexpr int BM = 256, BK = 64, HALF = 128, HTB = HALF * BK * 2  , STAGE_BYTES = 8 * HTB, NXCD = 8, WGM = 8;

__host__ __device__ __forceinline__ int lds_byte(int r, int c) { const int st = (r >> 4) * 2 + (c >> 5), rr = r & 15, cc = c & 31, ob = rr * 64 + cc * 2; return st * 1024 + (ob ^ (((ob >> 9) & 1) << 5)); }
__host__ __device__ __forceinline__ void stage_rc(int b, int& R, int& C) { const int st = b / 1024, sb = b % 1024, swz = sb ^ (((sb >> 9) & 1) << 5); R = (st >> 1) * 16 + swz / 64; C = (st & 1) * 32 + (swz % 64) / 2; }
__host__ __device__ __forceinline__ int perm32(int rho) { const int n = rho >> 4, i = rho & 15; return 8 * (i >> 2) + 4 * n + (i & 3); }

struct Unit { const char* A; const char* B; int pm, pn, nt, job, aux; };

struct StaticOrder {
    int nM, nN, nwg, G, c;
    __device__ void init(int M, int N, int G_, int c_) { nM = M / BM; nN = N / BM; nwg = nM * nN; G = G_; c = c_; }
    __device__ bool next(int i, int& pm, int& pn) const {
        const long L = (long)i * G + c; if (L >= nwg) return false;
        int wgid = (int)L; { const int q = nwg / NXCD, r = nwg % NXCD, xcd = wgid % NXCD, off = wgid / NXCD; wgid = (xcd < r ? xcd * (q + 1) : r * (q + 1) + (xcd - r) * q) + off; }
        const int nig = WGM * nN, gid = wgid / nig, fm = gid * WGM, gsz = (nM - fm) < WGM ? (nM - fm) : WGM;
        pm = fm + ((wgid % nig) % gsz); pn = (wgid % nig) / gsz; return true;
    }
};
struct SchedPlain {
    const char* A; const char* B; unsigned lda, ldb; int nt; StaticOrder so;
    __device__ __forceinline__ bool next(int i, Unit& u) const { int pm, pn; if (!so.next(i, pm, pn)) return false;
        u.pm = pm; u.pn = pn; u.A = A + (size_t)pm * BM * lda; u.B = B + (size_t)pn * BM * ldb; u.nt = nt; u.job = 0; u.aux = 0; return true; }
};

__device__ __forceinline__ unsigned cvt_pk_bf16(float lo, float hi) { unsigned r; asm volatile("v_cvt_pk_bf16_f32 %0, %1, %2" : "=v"(r) : "v"(lo), "v"(hi)); return r; }
__device__ __forceinline__ float bf_lo(unsigned w) { return __uint_as_float(w << 16); }
__device__ __forceinline__ float bf_hi(unsigned w) { return __uint_as_float(w & 0xffff0000u); }


#define PG8_OPAQUE(p) asm volatile("" : "+s"(p))
#define PG8_PIN(v) asm volatile("" : "+v"(v))
template <class T> __device__ __forceinline__ T ldg(const void* base, unsigned boff) { return *(const __attribute__((address_space(1))) T*)((const __attribute__((address_space(1))) char*)base + boff); }
template <class T> __device__ __forceinline__ void stg(void* base, unsigned boff, T v) { *(__attribute__((address_space(1))) T*)((__attribute__((address_space(1))) char*)base + boff) = v; }

template <int ACT, int LDC> struct EpiBf16 {
    static constexpr bool PERM = true;
    bf16_t* O; const unsigned long long* rowss;
    __device__ __forceinline__ void operator()(const f32x4 (&acc)[2][2][4][2], const Unit& u, int wr, int wc, int fr, int fq) const {
        char* ob = (char*)O + ((size_t)u.pm * BM * LDC + (size_t)u.pn * BM) * 2;
        PG8_OPAQUE(ob);
        unsigned l0 = ((unsigned)(wr * 64 + fr) * LDC + (unsigned)(wc * 32 + 8 * fq)) * 2u; PG8_PIN(l0);
        float rs[2][4];
        if (rowss) { const char* rsb = (const char*)rowss + (size_t)u.pm * BM * 8; PG8_OPAQUE(rsb); unsigned r0 = (unsigned)(wr * 64 + fr) * 8u; PG8_PIN(r0);
#pragma unroll
            for (int ai = 0; ai < 2; ++ai)
#pragma unroll
                for (int m = 0; m < 4; ++m) rs[ai][m] = __builtin_amdgcn_rsqf((float)ldg<unsigned long long>(rsb, r0 + (unsigned)((ai * HALF + m * 16) * 8)) * (1.f / (4096.f * 16777216.f)) + 1e-6f);
        } else {
#pragma unroll
            for (int ai = 0; ai < 2; ++ai)
#pragma unroll
                for (int m = 0; m < 4; ++m) rs[ai][m] = 1.f; }
#pragma unroll
        for (int ai = 0; ai < 2; ++ai)
#pragma unroll
            for (int m = 0; m < 4; ++m)
#pragma unroll
                for (int bj = 0; bj < 2; ++bj) { f32x4 v0 = acc[ai][bj][m][0] * rs[ai][m], v1 = acc[ai][bj][m][1] * rs[ai][m];
                    if (ACT == 2) {
#pragma unroll
                        for (int j = 0; j < 4; ++j) { const float a = fmaxf(v0[j], 0.f), b = fmaxf(v1[j], 0.f); v0[j] = a * a; v1[j] = b * b; } }
                    u32x4 w; w.x = cvt_pk_bf16(v0[0], v0[1]); w.y = cvt_pk_bf16(v0[2], v0[3]); w.z = cvt_pk_bf16(v1[0], v1[1]); w.w = cvt_pk_bf16(v1[2], v1[3]);
                    stg<u32x4>(ob, l0 + (unsigned)((ai * HALF + m * 16) * LDC + bj * HALF) * 2u, w); }
    }
};

struct EpiQKV {
    static constexpr bool PERM = true;
    bf16_t* Q; size_t stride; const float* ct; const float* st;
    __device__ __forceinline__ void operator()(const f32x4 (&acc)[2][2][4][2], const Unit& u, int wr, int wc, int fr, int fq) const {
        const int t = u.pn >> 4, hd = u.pn & 15, bb = u.pm >> 4, s0 = (u.pm & 15) * BM;
        char* ob = (char*)(Q + (size_t)t * stride) + (((size_t)(bb * 16 + hd) * 2) * 4096 + (size_t)s0) * 256;
        unsigned l0 = ((unsigned)(wr * 64 + fr) * 128u + (unsigned)(wc * 32 + 8 * fq)) * 2u; PG8_PIN(l0);
        const char* ctb = (const char*)ct + (size_t)u.pm * BM * 64; const char* stb = (const char*)st + (size_t)u.pm * BM * 64;
        PG8_OPAQUE(ob); PG8_OPAQUE(ctb); PG8_OPAQUE(stb);
        unsigned t0 = (unsigned)(wr * 64 + fr) * 64u + (unsigned)(8 * (fq & 1)) * 4u; PG8_PIN(t0);
        const bool rot = (t < 2) && (wc == 0);
#pragma unroll
        for (int g = 0; g < 4; ++g) {
            const int ai = g >> 1, mb = 2 * (g & 1);
            f32x4 c0[2], c1[2], s0[2], s1[2];
            if (rot) {
#pragma unroll
                for (int m = 0; m < 2; ++m) { const unsigned to = t0 + (unsigned)(ai * HALF + (mb + m) * 16) * 64u;
                    c0[m] = ldg<f32x4>(ctb, to); c1[m] = ldg<f32x4>(ctb, to + 16); s0[m] = ldg<f32x4>(stb, to); s1[m] = ldg<f32x4>(stb, to + 16);
                    if (fq < 2) { s0[m] = -s0[m]; s1[m] = -s1[m]; } }
                asm volatile("" ::: "memory"); }
#pragma unroll
            for (int m = 0; m < 2; ++m) {
#pragma unroll
                for (int bj = 0; bj < 2; ++bj) { f32x4 v0 = acc[ai][bj][mb + m][0], v1 = acc[ai][bj][mb + m][1];
                    if (rot) { f32x4 y0, y1;
#pragma unroll
                        for (int j = 0; j < 4; ++j) {
                            const auto ra = __builtin_amdgcn_permlane32_swap(__float_as_uint(v0[j]), __float_as_uint(v0[j]), false, false), rb = __builtin_amdgcn_permlane32_swap(__float_as_uint(v1[j]), __float_as_uint(v1[j]), false, false);
                            y0[j] = __uint_as_float(fq < 2 ? ra[1] : ra[0]); y1[j] = __uint_as_float(fq < 2 ? rb[1] : rb[0]); }
                        v0 = v0 * c0[m] + y0 * s0[m]; v1 = v1 * c1[m] + y1 * s1[m]; }
                    u32x4 w; w.x = cvt_pk_bf16(v0[0], v0[1]); w.y = cvt_pk_bf16(v0[2], v0[3]); w.z = cvt_pk_bf16(v1[0], v1[1]); w.w = cvt_pk_bf16(v1[2], v1[3]);
                    stg<u32x4>(ob, l0 + (unsigned)((ai * HALF + (mb + m) * 16) * 128 + bj * (4096 * 128)) * 2u, w); } }
            asm volatile("" ::: "memory"); }
    }
};

template <int LDC, bool BASE32> struct EpiRes {
    static constexpr bool PERM = true;
    const void* base; bf16_t* out; unsigned long long* rowss;
    __device__ __forceinline__ void operator()(const f32x4 (&acc)[2][2][4][2], const Unit& u, int wr, int wc, int fr, int fq) const {
        const size_t ue = (size_t)u.pm * BM * LDC + (size_t)u.pn * BM;
        const char* bb = (const char*)base + ue * (BASE32 ? 4 : 2); char* ob = (char*)out + ue * 2; char* rsb = (char*)rowss + (size_t)u.pm * BM * 8;
        PG8_OPAQUE(bb); PG8_OPAQUE(ob); PG8_OPAQUE(rsb);
        const bool stats = rowss != nullptr;
        unsigned l0 = (unsigned)(wr * 64 + fr) * LDC + (unsigned)(wc * 32 + 8 * fq); PG8_PIN(l0);
        unsigned r0 = (unsigned)(wr * 64 + fr) * 8u; PG8_PIN(r0);
#pragma unroll
        for (int ai = 0; ai < 2; ++ai) {
            f32x4 b[4][2][2];
#pragma unroll
            for (int m = 0; m < 4; ++m)
#pragma unroll
                for (int bj = 0; bj < 2; ++bj) { const unsigned e = l0 + (unsigned)((ai * HALF + m * 16) * LDC + bj * HALF);
                    if (BASE32) { b[m][bj][0] = ldg<f32x4>(bb, e * 4u); b[m][bj][1] = ldg<f32x4>(bb, e * 4u + 16u); }
                    else { const u32x4 w = ldg<u32x4>(bb, e * 2u); b[m][bj][0] = (f32x4){bf_lo(w.x), bf_hi(w.x), bf_lo(w.y), bf_hi(w.y)}; b[m][bj][1] = (f32x4){bf_lo(w.z), bf_hi(w.z), bf_lo(w.w), bf_hi(w.w)}; } }
            asm volatile("" ::: "memory");
#pragma unroll
            for (int m = 0; m < 4; ++m) { float ss = 0.f;
#pragma unroll
                for (int bj = 0; bj < 2; ++bj) { const unsigned e = l0 + (unsigned)((ai * HALF + m * 16) * LDC + bj * HALF);
                    const f32x4 v0 = b[m][bj][0] + acc[ai][bj][m][0], v1 = b[m][bj][1] + acc[ai][bj][m][1];
                    u32x4 w; w.x = cvt_pk_bf16(v0[0], v0[1]); w.y = cvt_pk_bf16(v0[2], v0[3]); w.z = cvt_pk_bf16(v1[0], v1[1]); w.w = cvt_pk_bf16(v1[2], v1[3]);
                    stg<u32x4>(ob, e * 2u, w);
                    ss += ((v0[0] * v0[0] + v0[1] * v0[1]) + (v0[2] * v0[2] + v0[3] * v0[3])) + ((v1[0] * v1[0] + v1[1] * v1[1]) + (v1[2] * v1[2] + v1[3] * v1[3])); }
                if (stats) {
                    { const auto r = __builtin_amdgcn_permlane16_swap(__float_as_uint(ss), __float_as_uint(ss), false, false); ss = __uint_as_float(r[0]) + __uint_as_float(r[1]); }
                    { const auto r = __builtin_amdgcn_permlane32_swap(__float_as_uint(ss), __float_as_uint(ss), false, false); ss = __uint_as_float(r[0]) + __uint_as_float(r[1]); }
                    if (fq == 0) (void)__hip_atomic_fetch_add((unsigned long long*)(rsb + r0 + (unsigned)((ai * HALF + m * 16) * 8)), (unsigned long long)(ss * 16777216.f), __ATOMIC_RELAXED, __HIP_MEMORY_SCOPE_AGENT); } }
            asm volatile("" ::: "memory");
        }
    }
};

struct EpiX1 {
    static constexpr bool PERM = false;
    float* slab; bf16_t* kv0; bf16_t* kv1; const unsigned long long* rowss;
    __device__ __forceinline__ void operator()(const f32x4 (&acc)[2][2][4][2], const Unit& u, int wr, int wc, int fr, int fq) const {
        if (u.job == 0) { char* ob = (char*)slab + ((size_t)u.aux * ((size_t)8192 * 512) + (size_t)u.pm * BM * 512 + (size_t)u.pn * BM) * 4;
            PG8_OPAQUE(ob);
            unsigned l0 = ((unsigned)(wr * 64 + fr) * 512u + (unsigned)(wc * 32 + 4 * fq)) * 4u; PG8_PIN(l0);
            const char* rsb = (const char*)rowss + (size_t)u.pm * BM * 8; PG8_OPAQUE(rsb); unsigned r0 = (unsigned)(wr * 64 + fr) * 8u; PG8_PIN(r0);
#pragma unroll
            for (int ai = 0; ai < 2; ++ai)
#pragma unroll
                for (int m = 0; m < 4; ++m) { const float rs = __builtin_amdgcn_rsqf((float)ldg<unsigned long long>(rsb, r0 + (unsigned)((ai * HALF + m * 16) * 8)) * (1.f / (4096.f * 16777216.f)) + 1e-6f);
#pragma unroll
                    for (int bj = 0; bj < 2; ++bj)
#pragma unroll
                        for (int n = 0; n < 2; ++n) stg<f32x4>(ob, l0 + (unsigned)((ai * HALF + m * 16) * 512 + bj * HALF + n * 16) * 4u, acc[ai][bj][m][n] * rs); }
        } else { char* ob = (char*)(u.aux ? kv1 : kv0) + ((size_t)u.pm * BM * 1024 + (size_t)u.pn * BM) * 2;
            PG8_OPAQUE(ob);
            unsigned l0 = ((unsigned)(wr * 64 + fr) * 1024u + (unsigned)(wc * 32 + 4 * fq)) * 2u; PG8_PIN(l0);
#pragma unroll
            for (int ai = 0; ai < 2; ++ai)
#pragma unroll
                for (int m = 0; m < 4; ++m)
#pragma unroll
                    for (int bj = 0; bj < 2; ++bj)
#pragma unroll
                        for (int n = 0; n < 2; ++n) { const f32x4 v = acc[ai][bj][m][n]; u32x2 w; w.x = cvt_pk_bf16(v[0], v[1]); w.y = cvt_pk_bf16(v[2], v[3]);
                            stg<u32x2>(ob, l0 + (unsigned)((ai * HALF + m * 16) * 1024 + bj * HALF + n * 16) * 2u, w); }
        }
    }
};

struct EpiGates {
    static constexpr bool PERM = false;
    const bf16_t* uc; const float* ba[2]; const float* bi[2]; const float* sp8[2]; unsigned* G; float* aggA; float* aggH;
    __device__ __forceinline__ void operator()(const f32x4 (&acc)[2][2][4][2], const Unit& u, int wr, int wc, int fr, int fq) const {
        const int dir = (u.aux >> 5) & 1, nb = (u.aux >> 1) & 15, half = u.aux & 1;
        const int chu = nb * 256 + half * 128;
        const char* bap = (const char*)(dir ? ba[1] : ba[0]) + chu * 4; const char* bip = (const char*)(dir ? bi[1] : bi[0]) + chu * 4; const char* spp = (const char*)(dir ? sp8[1] : sp8[0]) + chu * 4;
        const char* ucb = (const char*)uc + ((size_t)u.pm * BM * 4096 + chu) * 2;
        char* gb = (char*)G + ((size_t)dir * ((size_t)8192 * 4096) + (size_t)u.pm * BM * 4096 + chu) * 4;
        PG8_OPAQUE(bap); PG8_OPAQUE(bip); PG8_OPAQUE(spp); PG8_OPAQUE(ucb); PG8_OPAQUE(gb);
        unsigned chl = (unsigned)(wc * 32 + 4 * fq), rl = (unsigned)(wr * 64 + fr) * 4096u; PG8_PIN(chl); PG8_PIN(rl);
        u32x2 uwa[2][2][4];
#pragma unroll
        for (int n = 0; n < 2; ++n)
#pragma unroll
            for (int ai = 0; ai < 2; ++ai)
#pragma unroll
                for (int m = 0; m < 4; ++m) uwa[n][ai][m] = ldg<u32x2>(ucb, (rl + (unsigned)((ai * HALF + m * 16) * 4096) + chl + 16u * n) * 2u);
        asm volatile("" ::: "memory");
#pragma unroll
        for (int n = 0; n < 2; ++n) { const unsigned c = chl + 16u * n;
            const f32x4 vba = ldg<f32x4>(bap, c * 4u), vbi = ldg<f32x4>(bip, c * 4u), vsp = ldg<f32x4>(spp, c * 4u);
#pragma unroll
            for (int ai = 0; ai < 2; ++ai)
#pragma unroll
                for (int m = 0; m < 4; ++m) { const unsigned eo = rl + (unsigned)((ai * HALF + m * 16) * 4096) + c;
                    const u32x2 uw = uwa[n][ai][m]; const float uv[4] = {bf_lo(uw.x), bf_hi(uw.x), bf_lo(uw.y), bf_hi(uw.y)};
                    f32x4 pa = acc[ai][0][m][n], pi = acc[ai][1][m][n]; asm volatile("" : "+v"(pa), "+v"(pi));
                    pa += vba; pi += vbi; u32x4 w;
#pragma unroll
                    for (int j = 0; j < 4; ++j) {
                        const float r = __builtin_amdgcn_rcpf(1.f + __builtin_amdgcn_exp2f(-1.4426950408889634f * pa[j]));
                        const float ig = __builtin_amdgcn_rcpf(1.f + __builtin_amdgcn_exp2f(-1.4426950408889634f * pi[j]));
                        const float la = -r * vsp[j];
                        const float om = 1.f - __builtin_amdgcn_exp2f(2.8853900817779268f * la);
                        const float inp = __builtin_amdgcn_sqrtf(om) * (ig * uv[j]);
                        w[j] = cvt_pk_bf16(la, inp); }
                    stg<u32x4>(gb, eo * 4u, w); } }
        if ((u.aux & 64) != 0) {
            asm volatile("s_waitcnt vmcnt(0)" ::: "memory"); __builtin_amdgcn_s_barrier(); __builtin_amdgcn_fence(__ATOMIC_ACQUIRE, "agent");
            const int w8 = wr * 4 + wc, adir = w8 >> 2, ac = w8 & 3, b = u.pm >> 4, k = (u.pm & 15) * 4 + ac;
            const char* gp = (const char*)G + ((size_t)adir * ((size_t)8192 * 4096) + (size_t)(u.pm * BM + 64 * ac) * 4096 + (size_t)nb * 256) * 4; PG8_OPAQUE(gp);
            unsigned lo = (unsigned)(fq * 16 + fr) * 16u; PG8_PIN(lo);
            f32x4 sla = {0.f, 0.f, 0.f, 0.f}, H = {0.f, 0.f, 0.f, 0.f};
#pragma unroll 8
            for (int s_ = 0; s_ < 64; ++s_) { const int t = adir ? 63 - s_ : s_; const u32x4 w = ldg<u32x4>(gp, lo + (unsigned)t * 16384u);
#pragma unroll
                for (int j = 0; j < 4; ++j) { const float la = bf_lo(w[j]), inp = bf_hi(w[j]); H[j] = fmaf(__builtin_amdgcn_exp2f(la * 1.4426950408889634f), H[j], inp); sla[j] += la; } }
            const size_t ao = ((size_t)((adir * 2 + b) * 64 + k) * 4096 + (size_t)nb * 256) * 4;
            char* pa = (char*)aggA + ao; char* ph = (char*)aggH + ao; PG8_OPAQUE(pa); PG8_OPAQUE(ph);
            stg<f32x4>(pa, lo, sla); stg<f32x4>(ph, lo, H);
        }
    }
};

template <class Epi, class Sched, bool ALIGN_EPI>
__device__ __forceinline__ void gemm_phase(PG8_LAS unsigned char* lds, const unsigned lda, const unsigned ldb, const Sched& S, const Epi& E, const int wave_id) {
    int tid = wave_id * 64 + lane_now(); asm volatile("" : "+v"(tid));
    const int wid = __builtin_amdgcn_readfirstlane(tid >> 6), lane = tid & 63, wr = wid >> 2, wc = wid & 3, fr = lane & 15, fq = lane >> 4;
    unsigned voffA[2], voffB[2];
#pragma unroll
    for (int i = 0; i < 2; ++i) { int R, C; stage_rc(tid * 16 + i * 8192, R, C); const int Rb = Epi::PERM ? ((R & ~31) + perm32(R & 31)) : R;
        voffA[i] = (unsigned)R * lda + (unsigned)C * 2u; voffB[i] = (unsigned)Rb * ldb + (unsigned)C * 2u; }
    const size_t kstep = (size_t)(BK * 2);
    const size_t hstepA = (size_t)HALF * lda, hstepB = (size_t)HALF * ldb;
    const unsigned ldsw = (unsigned)wid * 1024u;
    const int aoff = lds_byte(wr * 64 + fr, fq * 8), boff = lds_byte(wc * 32 + fr, fq * 8);
#define PG8_SA(b, h) (((b) * 2 + (h)) * HTB)
#define PG8_SB(b, h) ((4 + (b) * 2 + (h)) * HTB)
#define PG8_STAGE(bufoff, gbase, voff) do { _Pragma("unroll") for (int _i = 0; _i < 2; ++_i) \
        __builtin_amdgcn_global_load_lds((const unsigned*)((const char*)(gbase) + (voff)[_i]), (PG8_LAS unsigned*)(lds + (bufoff) + ldsw + _i * 8192), 16, 0, 0); } while (0)
#define PG8_LDA(dst, b, h) do { _Pragma("unroll") for (int m = 0; m < 4; ++m) _Pragma("unroll") for (int k = 0; k < 2; ++k) dst[m][k] = *(const PG8_LAS bf16x8*)(lds + PG8_SA(b, h) + aoff + m * 2048 + k * 1024); } while (0)
#define PG8_LDB(dst, b, h) do { _Pragma("unroll") for (int n = 0; n < 2; ++n) _Pragma("unroll") for (int k = 0; k < 2; ++k) dst[n][k] = *(const PG8_LAS bf16x8*)(lds + PG8_SB(b, h) + boff + n * 2048 + k * 1024); } while (0)
#define PG8_MMA(ai, bj, At, Bt) do { __builtin_amdgcn_s_setprio(1); _Pragma("unroll") for (int m = 0; m < 4; ++m) _Pragma("unroll") for (int n = 0; n < 2; ++n) _Pragma("unroll") for (int k = 0; k < 2; ++k) \
        acc[ai][bj][m][n] = __builtin_amdgcn_mfma_f32_16x16x32_bf16(Bt[n][k], At[m][k], acc[ai][bj][m][n], 0, 0, 0); __builtin_amdgcn_s_setprio(0); } while (0)
#define PG8_WAIT_V(n) asm volatile("s_waitcnt vmcnt(" #n ")" ::: "memory")
#define PG8_WAIT_L(n) asm volatile("s_waitcnt lgkmcnt(" #n ")" ::: "memory")
#define PG8_BAR __builtin_amdgcn_s_barrier()
#define PG8_SCHED __builtin_amdgcn_sched_barrier(0)
    Unit cur, nxt; int ui = 0;
    if (!S.next(0, cur)) return;
    f32x4 acc[2][2][4][2];
#pragma unroll
    for (int a = 0; a < 2; ++a)
#pragma unroll
        for (int b = 0; b < 2; ++b)
#pragma unroll
            for (int m = 0; m < 4; ++m)
#pragma unroll
                for (int n = 0; n < 2; ++n) acc[a][b][m][n] = (f32x4){0.f, 0.f, 0.f, 0.f};
    bf16x8 At[4][2], B0[2][2], B1[2][2];
    const char* cA = cur.A; const char* cB = cur.B;
    PG8_STAGE(PG8_SB(0, 0), cB, voffB); PG8_STAGE(PG8_SB(0, 1), cB + hstepB, voffB); PG8_STAGE(PG8_SA(0, 0), cA, voffA); PG8_STAGE(PG8_SA(0, 1), cA + hstepA, voffA);
    if (wr == 1) PG8_BAR;
    PG8_WAIT_V(2); PG8_BAR;
    PG8_STAGE(PG8_SB(1, 0), cB + kstep, voffB); PG8_STAGE(PG8_SA(1, 0), cA + kstep, voffA); PG8_STAGE(PG8_SB(1, 1), cB + hstepB + kstep, voffB);
    PG8_WAIT_V(6); PG8_BAR;
    for (;;) {
        const bool has_next = S.next(ui + 1, nxt);
        const char* nA = has_next ? nxt.A : cA; const char* nB = has_next ? nxt.B : cB;
        int nt = cur.nt; asm volatile("" : "+s"(nt));
        for (int t = 0; t < nt; t += 2) {
            const bool last = (t == nt - 2);
            const char* a1 = cA + (size_t)(t + 1) * kstep;
            const char* a2 = last ? nA : cA + (size_t)(t + 2) * kstep; const char* b2 = last ? nB : cB + (size_t)(t + 2) * kstep;
            const char* a3 = a2 + kstep; const char* b3 = b2 + kstep;
            PG8_LDB(B0, 0, 0); PG8_LDB(B1, 0, 1); PG8_SCHED; PG8_LDA(At, 0, 0); PG8_STAGE(PG8_SA(1, 1), a1 + hstepA, voffA);
            PG8_WAIT_V(8); PG8_WAIT_L(0); PG8_BAR; PG8_MMA(0, 0, At, B0); PG8_MMA(0, 1, At, B1); PG8_BAR; PG8_SCHED;
            PG8_LDA(At, 0, 1); PG8_STAGE(PG8_SB(0, 0), b2, voffB); PG8_STAGE(PG8_SB(0, 1), b2 + hstepB, voffB); PG8_STAGE(PG8_SA(0, 0), a2, voffA);
            PG8_WAIT_V(8); PG8_WAIT_L(0); PG8_BAR; PG8_MMA(1, 0, At, B0); PG8_MMA(1, 1, At, B1); PG8_BAR; PG8_SCHED;
            PG8_LDB(B0, 1, 0); PG8_LDB(B1, 1, 1); PG8_SCHED; PG8_LDA(At, 1, 0); PG8_STAGE(PG8_SA(0, 1), a2 + hstepA, voffA);
            PG8_WAIT_V(8); PG8_WAIT_L(0); PG8_BAR; PG8_MMA(0, 0, At, B0); PG8_MMA(0, 1, At, B1); PG8_BAR; PG8_SCHED;
            PG8_LDA(At, 1, 1); PG8_STAGE(PG8_SB(1, 0), b3, voffB); PG8_STAGE(PG8_SB(1, 1), b3 + hstepB, voffB); PG8_STAGE(PG8_SA(1, 0), a3, voffA);
            PG8_WAIT_V(8); PG8_WAIT_L(0); PG8_BAR; PG8_MMA(1, 0, At, B0); PG8_MMA(1, 1, At, B1); PG8_BAR; PG8_SCHED;
        }
        if constexpr (ALIGN_EPI) { if (wr == 0) PG8_BAR; }
        E(acc, cur, wr, wc, fr, fq);
        if (!has_next) break;
#pragma unroll
        for (int a = 0; a < 2; ++a)
#pragma unroll
            for (int b = 0; b < 2; ++b)
#pragma unroll
                for (int m = 0; m < 4; ++m)
#pragma unroll
                    for (int n = 0; n < 2; ++n) acc[a][b][m][n] = (f32x4){0.f, 0.f, 0.f, 0.f};
        cur = nxt; cA = nA; cB = nB; ++ui;
        if constexpr (ALIGN_EPI) { if (wr == 1) PG8_BAR; }
    }
    PG8_WAIT_V(0);
    if constexpr (!ALIGN_EPI) { if (wr == 0) PG8_BAR; }
    PG8_BAR;
#undef PG8_SA
#undef PG8_SB
#undef PG8_STAGE
#undef PG8_LDA
#undef PG8_LDB
#undef PG8_MMA
#undef PG8_WAIT_V
#undef PG8_WAIT_L
#undef PG8_BAR
#undef PG8_SCHED
}
}
namespace att {
using bf16x8 = __attribute__((ext_vector_type(8))) short;
using s16x4  = __attribute__((ext_vector_type(4))) short;
using f32x16 = __attribute__((ext_vector_type(16))) float;
using f32x8  = __attribute__((ext_vector_type(8))) float;
using u32x4  = __attribute__((ext_vector_type(4))) unsigned;
using f32x4  = __attribute__((ext_vector_type(4))) float;
typedef unsigned short bf16_t;
constexpr int D = 128, NW = 8, QBLK = 32, KVBLK = 64;
constexpr float SCALE = 0.088388347648318440f;
constexpr float THR = 8.f;
constexpr size_t SHM_V = KVBLK * D * 2, SHM_K = KVBLK * D * 2, SHM_ATTN = 2 * SHM_V + 2 * SHM_K + NW * 64 * 4;
#define KSWZ(row, colB) ((row) * 256 + ((colB) ^ (((row) & 15) << 4)))
#define SBAR() __builtin_amdgcn_sched_barrier(0)
__device__ __forceinline__ int crow(int r, int hi) { return (r & 3) + 8 * (r >> 2) + 4 * hi; }
__device__ __forceinline__ unsigned cvtpk(float lo, float hi) { unsigned r; asm volatile("v_cvt_pk_bf16_f32 %0, %1, %2" : "=v"(r) : "v"(lo), "v"(hi)); return r; }
__device__ __forceinline__ bf16x8 tobf(f32x8 x) { u32x4 w = {cvtpk(x[0], x[1]), cvtpk(x[2], x[3]), cvtpk(x[4], x[5]), cvtpk(x[6], x[7])}; return *reinterpret_cast<bf16x8*>(&w); }

__device__ __forceinline__ void partialSM(f32x16& p0, f32x16& p1, float& m_reg, float& mn, float& alpha) {
  constexpr float C = SCALE * 1.4426950408889634f;
  float pmax = p0[0]; for (int r = 1; r < 16; ++r) pmax = fmaxf(pmax, p0[r]); for (int r = 0; r < 16; ++r) pmax = fmaxf(pmax, p1[r]);
  { auto rr = __builtin_amdgcn_permlane32_swap(__float_as_uint(pmax), __float_as_uint(pmax), false, false);
    pmax = fmaxf(__uint_as_float(rr[0]), __uint_as_float(rr[1])); }
  if (__builtin_expect(__all(pmax - m_reg <= THR / SCALE), 1)) { mn = m_reg; alpha = 1.f; }
  else { mn = fmaxf(m_reg, pmax); alpha = __builtin_amdgcn_exp2f((m_reg - mn) * C); m_reg = mn; }
  float mnC = -mn * C;
  for (int r = 0; r < 16; ++r) p0[r] = fmaf(p0[r], C, mnC); for (int r = 0; r < 16; ++r) p1[r] = fmaf(p1[r], C, mnC);
  for (int r = 0; r < 16; ++r) p0[r] = __builtin_amdgcn_exp2f(p0[r]);
}
__device__ __forceinline__ void finishSM(f32x16& p0, f32x16& p1, float alpha, float& l_reg, bf16x8& pa0, bf16x8& pa1, bf16x8& pa2, bf16x8& pa3) {
  for (int r = 0; r < 16; ++r) p1[r] = __builtin_amdgcn_exp2f(p1[r]);
  float ps = 0; for (int r = 0; r < 16; ++r) ps += p0[r]; for (int r = 0; r < 16; ++r) ps += p1[r];
  { auto rr = __builtin_amdgcn_permlane32_swap(__float_as_uint(ps), __float_as_uint(ps), false, false);
    ps = __uint_as_float(rr[0]) + __uint_as_float(rr[1]); }
  l_reg = l_reg * alpha + ps;
#define PK4(P, BASE, OUT) do { unsigned a0 = cvtpk(P[BASE + 0], P[BASE + 1]), a1 = cvtpk(P[BASE + 2], P[BASE + 3]);   \
    unsigned b0 = cvtpk(P[BASE + 4], P[BASE + 5]), b1 = cvtpk(P[BASE + 6], P[BASE + 7]);                              \
    auto r0 = __builtin_amdgcn_permlane32_swap(a0, b0, false, false); auto r1 = __builtin_amdgcn_permlane32_swap(a1, b1, false, false); \
    u32x4 w = {r0[0], r1[0], r0[1], r1[1]}; OUT = *reinterpret_cast<bf16x8*>(&w); } while (0)
  PK4(p0, 0, pa0); PK4(p0, 8, pa1); PK4(p1, 0, pa2); PK4(p1, 8, pa3);
#undef PK4
}
__device__ __forceinline__ void qkt(f32x16& p0, f32x16& p1, const bf16_t* Ks, const bf16x8* qr, int r32, int hi) {
  p0 = f32x16{}; p1 = f32x16{};
#pragma unroll
  for (int d0 = 0; d0 < 8; ++d0) { int cb = (d0 * 16 + hi * 8) * 2;
    bf16x8 b0 = *reinterpret_cast<const bf16x8*>((const char*)Ks + KSWZ(r32, cb));
    bf16x8 b1 = *reinterpret_cast<const bf16x8*>((const char*)Ks + KSWZ(32 + r32, cb));
    p0 = __builtin_amdgcn_mfma_f32_32x32x16_bf16(b0, qr[d0], p0, 0, 0, 0);
    p1 = __builtin_amdgcn_mfma_f32_32x32x16_bf16(b1, qr[d0], p1, 0, 0, 0); }
}
__device__ __forceinline__ int v_st(int k, int c) { const int kk = (k & ~0xC) | ((k & 4) << 1) | ((k & 8) >> 1); return ((kk >> 3) * 4 + (c >> 5)) * 512 + ((kk & 7) * 32 + (c & 31)) * 2; }
__device__ __forceinline__ int v_rd_base(int lane) { return ((lane & 3) << 3) | (((lane >> 2) & 3) << 6) | (((lane >> 4) & 1) << 5) | (((lane >> 5) & 1) << 8); }
constexpr int v_rd_off(int d0, int ks, int half) { return d0 * 512 + ks * 4096 + half * 2048; }
template <int OFF> __device__ __forceinline__ s16x4 tr_read(int vb) {
  s16x4 r; asm volatile("ds_read_b64_tr_b16 %0, %1 offset:%2" : "=&v"(r) : "v"(vb), "i"(OFF) : "memory"); return r;
}
template <int D0> __device__ __forceinline__ void pv_one(f32x16& od, int vb, bf16x8 pa0, bf16x8 pa1, bf16x8 pa2, bf16x8 pa3) {
  const s16x4 l0 = tr_read<v_rd_off(D0, 0, 0)>(vb), h0 = tr_read<v_rd_off(D0, 0, 1)>(vb), l1 = tr_read<v_rd_off(D0, 1, 0)>(vb), h1 = tr_read<v_rd_off(D0, 1, 1)>(vb);
  const s16x4 l2 = tr_read<v_rd_off(D0, 2, 0)>(vb), h2 = tr_read<v_rd_off(D0, 2, 1)>(vb), l3 = tr_read<v_rd_off(D0, 3, 0)>(vb), h3 = tr_read<v_rd_off(D0, 3, 1)>(vb);
  asm volatile("s_waitcnt lgkmcnt(0)" ::: "memory"); SBAR();
#define PK(L, H) (bf16x8){L[0], L[1], L[2], L[3], H[0], H[1], H[2], H[3]}
  od = __builtin_amdgcn_mfma_f32_32x32x16_bf16(pa0, PK(l0, h0), od, 0, 0, 0);
  od = __builtin_amdgcn_mfma_f32_32x32x16_bf16(pa1, PK(l1, h1), od, 0, 0, 0);
  od = __builtin_amdgcn_mfma_f32_32x32x16_bf16(pa2, PK(l2, h2), od, 0, 0, 0);
  od = __builtin_amdgcn_mfma_f32_32x32x16_bf16(pa3, PK(l3, h3), od, 0, 0, 0);
#undef PK
}
__device__ __forceinline__ void pv_d0(f32x16* o, int vb, bf16x8 pa0, bf16x8 pa1, bf16x8 pa2, bf16x8 pa3) {
  pv_one<0>(o[0], vb, pa0, pa1, pa2, pa3); pv_one<1>(o[1], vb, pa0, pa1, pa2, pa3); pv_one<2>(o[2], vb, pa0, pa1, pa2, pa3); pv_one<3>(o[3], vb, pa0, pa1, pa2, pa3);
}

template <int QMODE, int OMODE, int LDQ, int LDK, int LDO, int SDEPTH>
__device__ __forceinline__ void attn_dense_body(const void* __restrict__ Qb_, size_t qslab, const bf16_t* __restrict__ Kh, const bf16_t* __restrict__ Vh,
                                                void* __restrict__ Ob_, int seq, char* lds, const int wave_id) {
  int tid = wave_id * 64 + pg8::lane_now(); asm volatile("" : "+v"(tid));
  const int wid = __builtin_amdgcn_readfirstlane(tid >> 6), lane = tid & 63, r32 = lane & 31, hi = lane >> 5;
  bf16_t* V_lds = (bf16_t*)lds; bf16_t* K_lds = (bf16_t*)(lds + 2 * SHM_V);
  float* ws = (float*)(lds + 2 * SHM_V + 2 * SHM_K) + wid * 64; float* li_l = ws; float* al_l = ws + 32;
  float m_reg = -1e30f, l_reg = 0; f32x16 o[4] = {}; bf16x8 qr[8];
  if constexpr (QMODE == 0) {
    const bf16_t* Qw = (const bf16_t*)Qb_ + (long)(wid * QBLK + r32) * LDQ + hi * 8;
#pragma unroll
    for (int d0 = 0; d0 < 8; ++d0) qr[d0] = *reinterpret_cast<const bf16x8*>(Qw + d0 * 16);
  } else {
    const float* Qw = (const float*)Qb_ + (long)(wid * QBLK + r32) * LDQ + hi * 8;
#pragma unroll
    for (int d0 = 0; d0 < 8; ++d0) { f32x8 a = *reinterpret_cast<const f32x8*>(Qw + d0 * 16);
#pragma unroll
      for (int s = 1; s < 4; ++s) a += *reinterpret_cast<const f32x8*>(Qw + s * qslab + d0 * 16);
      qr[d0] = tobf(a); if (d0 & 1) { asm volatile("" ::: "memory"); SBAR(); } }
  }
  const int sr = tid >> 4, sc = (tid & 15) * 8, vst0 = v_st(sr, sc), vst1 = v_st(32 + sr, sc);
  const int vb0 = (int)(uintptr_t)V_lds + v_rd_base(lane);
  struct { bf16x8 vs0, vs1, ks0, ks1; } sr_[SDEPTH];
#define SLOAD(i, k0) do { sr_[i].vs0 = *reinterpret_cast<const bf16x8*>(&Vh[(long)((k0) + sr) * LDK + sc]); sr_[i].vs1 = *reinterpret_cast<const bf16x8*>(&Vh[(long)((k0) + 32 + sr) * LDK + sc]); \
    sr_[i].ks0 = *reinterpret_cast<const bf16x8*>(&Kh[(long)((k0) + sr) * LDK + sc]); sr_[i].ks1 = *reinterpret_cast<const bf16x8*>(&Kh[(long)((k0) + 32 + sr) * LDK + sc]); } while (0)
#define SWRITE(b, i) do { *(bf16x8*)((char*)V_lds + (b) * SHM_V + vst0) = sr_[i].vs0;          \
    *(bf16x8*)((char*)V_lds + (b) * SHM_V + vst1) = sr_[i].vs1; int kc = sc * 2;               \
    *(bf16x8*)((char*)K_lds + (b) * SHM_K + KSWZ(sr, kc)) = sr_[i].ks0;                       \
    *(bf16x8*)((char*)K_lds + (b) * SHM_K + KSWZ(32 + sr, kc)) = sr_[i].ks1; } while (0)
#define SWAIT() do { if constexpr (SDEPTH == 2) asm volatile("s_waitcnt vmcnt(4)" ::: "memory"); else asm volatile("s_waitcnt vmcnt(0)" ::: "memory"); } while (0)
#define RESC(a) do { if (__any((a) < 1.f)) { if (hi == 0) al_l[r32] = (a); asm volatile("s_waitcnt lgkmcnt(0)" ::: "memory"); \
    for (int d = 0; d < 4; ++d) for (int r = 0; r < 16; ++r) o[d][r] *= al_l[crow(r, hi)]; } } while (0)
  f32x16 pA0, pA1, pB0, pB1; float mnA, mnB, alA, alB; bf16x8 pa0, pa1, pa2, pa3; const int NT = seq / KVBLK;
  constexpr int SE = 0, SO = SDEPTH - 1;
  SLOAD(SE, 0); asm volatile("s_waitcnt vmcnt(0)" ::: "memory"); SWRITE(0, SE); __syncthreads();
  qkt(pA0, pA1, K_lds, qr, r32, hi); partialSM(pA0, pA1, m_reg, mnA, alA);
  SLOAD(SO, KVBLK); if constexpr (SDEPTH == 2) { if (2 < NT) SLOAD(SE, 2 * KVBLK); }
  SWAIT(); SWRITE(1, SO); __syncthreads();
  for (int j = 1; j + 1 < NT; j += 2) {
    SBAR(); qkt(pB0, pB1, (bf16_t*)((char*)K_lds + SHM_K), qr, r32, hi);
    finishSM(pA0, pA1, alA, l_reg, pa0, pa1, pa2, pa3); SBAR();
    SLOAD(SO, (j + SDEPTH) * KVBLK); SBAR();
    pv_d0(o, vb0, pa0, pa1, pa2, pa3); partialSM(pB0, pB1, m_reg, mnB, alB);
    __syncthreads(); SWAIT(); SWRITE(0, SE);
    RESC(alB); __syncthreads();
    SBAR(); qkt(pA0, pA1, K_lds, qr, r32, hi);
    finishSM(pB0, pB1, alB, l_reg, pa0, pa1, pa2, pa3); SBAR();
    if (SDEPTH == 1 || j + 3 < NT) SLOAD(SE, (j + 1 + SDEPTH) * KVBLK); SBAR();
    pv_d0(o, vb0 + (int)SHM_V, pa0, pa1, pa2, pa3); partialSM(pA0, pA1, m_reg, mnA, alA);
    __syncthreads(); SWAIT(); SWRITE(1, SO);
    RESC(alA); __syncthreads();
  }
  SBAR(); qkt(pB0, pB1, (bf16_t*)((char*)K_lds + SHM_K), qr, r32, hi);
  finishSM(pA0, pA1, alA, l_reg, pa0, pa1, pa2, pa3); SBAR();
  pv_d0(o, vb0, pa0, pa1, pa2, pa3); partialSM(pB0, pB1, m_reg, mnB, alB);
  __syncthreads(); RESC(alB);
  finishSM(pB0, pB1, alB, l_reg, pa0, pa1, pa2, pa3); SBAR();
  pv_d0(o, vb0 + (int)SHM_V, pa0, pa1, pa2, pa3);
  if (hi == 0) li_l[r32] = l_reg; asm volatile("s_waitcnt lgkmcnt(0)" ::: "memory");
  float rli[16];
#pragma unroll
  for (int r = 0; r < 16; ++r) rli[r] = __builtin_amdgcn_rcpf(li_l[crow(r, hi)]);
  {
    constexpr unsigned ES = (OMODE == 0) ? 4u : 2u;
    char* Owb = (char*)Ob_ + (size_t)(wid * QBLK) * LDO * ES; asm volatile("" : "+s"(Owb));
    unsigned lo = ((unsigned)(4 * hi) * LDO + (unsigned)r32) * ES; asm volatile("" : "+v"(lo));
#pragma unroll
    for (int r = 0; r < 16; ++r) {
#pragma unroll
      for (int d0 = 0; d0 < 4; ++d0) { const unsigned off = lo + (unsigned)(((r & 3) + 8 * (r >> 2)) * LDO + d0 * 32) * ES; const float v = o[d0][r] * rli[r];
        if constexpr (OMODE == 0) *(__attribute__((address_space(1))) float*)((__attribute__((address_space(1))) char*)Owb + off) = v; else *(__attribute__((address_space(1))) bf16_t*)((__attribute__((address_space(1))) char*)Owb + off) = (bf16_t)(cvtpk(v, 0.f) & 0xffffu); } }
  }
  __syncthreads();
#undef SLOAD
#undef SWRITE
#undef SWAIT
#undef RESC
}

constexpr size_t KS_V = 0, KS_K = 65536, KS_X = 98304, KS_W = 114688, KS_BYTES = 118784;
template <int LDQ, int LDK, int LDO, int STAGE>
__device__ __forceinline__ void attn_ks_body(const bf16_t* __restrict__ Qb, const bf16_t* __restrict__ Kh, const bf16_t* __restrict__ Vh, bf16_t* __restrict__ Ob, int seq, char* lds, const int wave_id,
                                             unsigned (&o0p)[4][8], const float lam, const float* __restrict__ gain, const float post) {
  int tid = wave_id * 64 + pg8::lane_now(); asm volatile("" : "+v"(tid));
  const int wid = __builtin_amdgcn_readfirstlane(tid >> 6), lane = tid & 63, r32 = lane & 31, hi = lane >> 5, rg = wid & 3, kh = wid >> 2;
  char* V_lds = lds + KS_V; char* K_lds = lds + KS_K;
  char* Xown = lds + KS_X + wid * 2048; char* Xpar = lds + KS_X + (wid ^ 4) * 2048;
  float* wsf = (float*)(lds + KS_W) + wid * 128; float* wsp = (float*)(lds + KS_W) + (wid ^ 4) * 128;
  float m_reg = -1e30f, l_reg = 0.f; f32x16 o[4] = {}; bf16x8 qr[8];
  { const bf16_t* Qw = Qb + (long)(rg * QBLK + r32) * LDQ + hi * 8;
#pragma unroll
    for (int d0 = 0; d0 < 8; ++d0) qr[d0] = *reinterpret_cast<const bf16x8*>(Qw + d0 * 16); }
  const int sr = tid >> 4, sc = (tid & 15) * 8, vst0 = v_st(sr, sc), vst1 = v_st(32 + sr, sc);
  const int vb_own = (int)(uintptr_t)V_lds + kh * 16384 + v_rd_base(lane) + kh * 8192;
  const int vb_par = (int)(uintptr_t)V_lds + kh * 16384 + v_rd_base(lane) + (kh ^ 1) * 8192;
  bf16x8 ks0, ks1, va0, va1, vb0_, vb1_;
#define KS_SLOADK(k0) do { ks0 = *reinterpret_cast<const bf16x8*>(&Kh[(long)((k0) + sr) * LDK + sc]); ks1 = *reinterpret_cast<const bf16x8*>(&Kh[(long)((k0) + 32 + sr) * LDK + sc]); } while (0)
#define KS_SLOADV(k0) do { va0 = *reinterpret_cast<const bf16x8*>(&Vh[(long)((k0) + sr) * LDK + sc]); va1 = *reinterpret_cast<const bf16x8*>(&Vh[(long)((k0) + 32 + sr) * LDK + sc]); \
    vb0_ = *reinterpret_cast<const bf16x8*>(&Vh[(long)((k0) + sr) * LDK + 128 + sc]); vb1_ = *reinterpret_cast<const bf16x8*>(&Vh[(long)((k0) + 32 + sr) * LDK + 128 + sc]); } while (0)
#define KS_SWRITEK(b) do { const int kc = sc * 2; *(bf16x8*)(K_lds + (b) * 16384 + KSWZ(sr, kc)) = ks0; *(bf16x8*)(K_lds + (b) * 16384 + KSWZ(32 + sr, kc)) = ks1; } while (0)
#define KS_SWRITEV(b) do { *(bf16x8*)(V_lds + (b) * 32768 + vst0) = va0; *(bf16x8*)(V_lds + (b) * 32768 + vst1) = va1; \
    *(bf16x8*)(V_lds + (b) * 32768 + 16384 + vst0) = vb0_; *(bf16x8*)(V_lds + (b) * 32768 + 16384 + vst1) = vb1_; } while (0)
#define KS_QKT(P, b) do { P = f32x16{}; const char* kb_ = K_lds + (b) * 16384; \
    _Pragma("unroll") for (int d0 = 0; d0 < 8; ++d0) { const int cb = (d0 * 16 + hi * 8) * 2; \
      const bf16x8 bq = *reinterpret_cast<const bf16x8*>(kb_ + KSWZ(32 * kh + r32, cb)); P = __builtin_amdgcn_mfma_f32_32x32x16_bf16(bq, qr[d0], P, 0, 0, 0); } } while (0)
#define KS_PMAX(P) do { float pm_ = P[0]; _Pragma("unroll") for (int r = 1; r < 16; ++r) pm_ = fmaxf(pm_, P[r]); \
    { auto rr = __builtin_amdgcn_permlane32_swap(__float_as_uint(pm_), __float_as_uint(pm_), false, false); pm_ = fmaxf(__uint_as_float(rr[0]), __uint_as_float(rr[1])); } \
    pmax_own = pm_; if (hi == 0) wsf[r32] = pm_; } while (0)
#define KS_SOFTMAX(P) do { constexpr float C = SCALE * 1.4426950408889634f; \
    const float pmax = fmaxf(pmax_own, wsp[r32]); float mn; \
    if (__builtin_expect(__all(pmax - m_reg <= THR / SCALE), 1)) { mn = m_reg; alpha = 1.f; } \
    else { mn = fmaxf(m_reg, pmax); alpha = __builtin_amdgcn_exp2f((m_reg - mn) * C); m_reg = mn; } \
    const float mnC = -mn * C; \
    _Pragma("unroll") for (int r = 0; r < 16; ++r) P[r] = __builtin_amdgcn_exp2f(fmaf(P[r], C, mnC)); \
    float ps = 0.f; _Pragma("unroll") for (int r = 0; r < 16; ++r) ps += P[r]; \
    { auto rr = __builtin_amdgcn_permlane32_swap(__float_as_uint(ps), __float_as_uint(ps), false, false); ps = __uint_as_float(rr[0]) + __uint_as_float(rr[1]); } \
    l_reg = l_reg * alpha + ps; \
    { unsigned a0 = cvtpk(P[0], P[1]), a1 = cvtpk(P[2], P[3]), b0 = cvtpk(P[4], P[5]), b1 = cvtpk(P[6], P[7]); \
      auto r0 = __builtin_amdgcn_permlane32_swap(a0, b0, false, false); auto r1 = __builtin_amdgcn_permlane32_swap(a1, b1, false, false); u32x4 w = {r0[0], r1[0], r0[1], r1[1]}; nown0 = *reinterpret_cast<bf16x8*>(&w); } \
    { unsigned a0 = cvtpk(P[8], P[9]), a1 = cvtpk(P[10], P[11]), b0 = cvtpk(P[12], P[13]), b1 = cvtpk(P[14], P[15]); \
      auto r0 = __builtin_amdgcn_permlane32_swap(a0, b0, false, false); auto r1 = __builtin_amdgcn_permlane32_swap(a1, b1, false, false); u32x4 w = {r0[0], r1[0], r0[1], r1[1]}; nown1 = *reinterpret_cast<bf16x8*>(&w); } \
    *(bf16x8*)(Xown + lane * 32) = nown0; *(bf16x8*)(Xown + lane * 32 + 16) = nown1; } while (0)
#define KS_RESC() do { if (__any(alpha < 1.f)) { if (hi == 0) wsf[32 + r32] = alpha; asm volatile("s_waitcnt lgkmcnt(0)" ::: "memory"); \
      _Pragma("unroll") for (int d = 0; d < 4; ++d) _Pragma("unroll") for (int r = 0; r < 16; ++r) o[d][r] *= wsf[32 + crow(r, hi)]; } } while (0)
#define KS_PVD(D0, b) do { const int o_ = vb_own + (b) * 32768, p_ = vb_par + (b) * 32768; \
    const s16x4 l0 = tr_read<v_rd_off(D0, 0, 0)>(o_), h0 = tr_read<v_rd_off(D0, 0, 1)>(o_), l1 = tr_read<v_rd_off(D0, 1, 0)>(o_), h1 = tr_read<v_rd_off(D0, 1, 1)>(o_); \
    const s16x4 l2 = tr_read<v_rd_off(D0, 0, 0)>(p_), h2 = tr_read<v_rd_off(D0, 0, 1)>(p_), l3 = tr_read<v_rd_off(D0, 1, 0)>(p_), h3 = tr_read<v_rd_off(D0, 1, 1)>(p_); \
    asm volatile("s_waitcnt lgkmcnt(0)" ::: "memory"); SBAR(); \
    o[D0] = __builtin_amdgcn_mfma_f32_32x32x16_bf16(own0, ((bf16x8){l0[0], l0[1], l0[2], l0[3], h0[0], h0[1], h0[2], h0[3]}), o[D0], 0, 0, 0); \
    o[D0] = __builtin_amdgcn_mfma_f32_32x32x16_bf16(own1, ((bf16x8){l1[0], l1[1], l1[2], l1[3], h1[0], h1[1], h1[2], h1[3]}), o[D0], 0, 0, 0); \
    o[D0] = __builtin_amdgcn_mfma_f32_32x32x16_bf16(par0, ((bf16x8){l2[0], l2[1], l2[2], l2[3], h2[0], h2[1], h2[2], h2[3]}), o[D0], 0, 0, 0); \
    o[D0] = __builtin_amdgcn_mfma_f32_32x32x16_bf16(par1, ((bf16x8){l3[0], l3[1], l3[2], l3[3], h3[0], h3[1], h3[2], h3[3]}), o[D0], 0, 0, 0); } while (0)
#define KS_PV(b) do { KS_PVD(0, b); KS_PVD(1, b); KS_PVD(2, b); KS_PVD(3, b); } while (0)
  f32x16 S; float pmax_own, alpha = 1.f; bf16x8 own0, own1, par0, par1, nown0, nown1; const int NT = seq / KVBLK;
  KS_SLOADK(0); KS_SLOADV(0); asm volatile("s_waitcnt vmcnt(0)" ::: "memory"); KS_SWRITEK(0); KS_SWRITEV(0); __syncthreads();
  KS_QKT(S, 0); KS_PMAX(S); KS_SLOADK(KVBLK); KS_SLOADV(KVBLK);
  __syncthreads();
  KS_SWRITEK(1); KS_SOFTMAX(S); KS_RESC(); own0 = nown0; own1 = nown1;
  __syncthreads();
  for (int t = 0; t + 1 < NT; ++t) {
    const int bt = t & 1, bn = bt ^ 1;
    KS_SWRITEV(bn);
    SBAR(); KS_QKT(S, bn);
    par0 = *(const bf16x8*)(Xpar + lane * 32); par1 = *(const bf16x8*)(Xpar + lane * 32 + 16);
    SBAR(); if (t + 2 < NT) KS_SLOADK((t + 2) * KVBLK); SBAR();
    KS_PVD(0, bt); KS_PVD(1, bt); KS_PMAX(S);
    __syncthreads();
    if (t + 2 < NT) { KS_SWRITEK(bt); KS_SLOADV((t + 2) * KVBLK); }
    KS_PVD(2, bt); KS_PVD(3, bt);
    KS_SOFTMAX(S);
    KS_RESC(); own0 = nown0; own1 = nown1;
    __syncthreads();
  }
  { const int bl = (NT - 1) & 1;
    par0 = *(const bf16x8*)(Xpar + lane * 32); par1 = *(const bf16x8*)(Xpar + lane * 32 + 16);
    SBAR(); KS_PV(bl); }
  if (hi == 0) wsf[r32] = l_reg;
  __syncthreads();
  { const float lt = l_reg + wsp[r32]; if (hi == 0) wsf[64 + r32] = lt; asm volatile("s_waitcnt lgkmcnt(0)" ::: "memory"); }
  float rli[16];
#pragma unroll
  for (int r = 0; r < 16; ++r) rli[r] = __builtin_amdgcn_rcpf(wsf[64 + crow(r, hi)]);
  if constexpr (STAGE == 0) {
#pragma unroll
    for (int d0 = 0; d0 < 4; ++d0)
#pragma unroll
      for (int i = 0; i < 8; ++i) o0p[d0][i] = cvtpk(o[d0][2 * i] * rli[2 * i], o[d0][2 * i + 1] * rli[2 * i + 1]);
  } else {
    float ssq[16];
#pragma unroll
    for (int r = 0; r < 16; ++r) ssq[r] = 0.f;
#pragma unroll
    for (int d0 = 0; d0 < 4; ++d0)
#pragma unroll
      for (int i = 0; i < 8; ++i) { const unsigned w = o0p[d0][i];
        const float da = __uint_as_float(w << 16) - lam * (o[d0][2 * i] * rli[2 * i]), db = __uint_as_float(w & 0xffff0000u) - lam * (o[d0][2 * i + 1] * rli[2 * i + 1]);
        o[d0][2 * i] = da; o[d0][2 * i + 1] = db; ssq[2 * i] += da * da; ssq[2 * i + 1] += db * db; }
    float* T = (float*)(K_lds + wid * 4096);
#pragma unroll
    for (int r = 0; r < 16; ++r) T[crow(r, hi) * 32 + r32] = ssq[r];
    asm volatile("s_waitcnt lgkmcnt(0)" ::: "memory");
    float tot = 0.f;
    { const f32x4* tp = (const f32x4*)(T + r32 * 32 + 16 * hi);
#pragma unroll
      for (int q = 0; q < 4; ++q) { const f32x4 v = tp[q]; tot += (v[0] + v[1]) + (v[2] + v[3]); } }
    { auto rr = __builtin_amdgcn_permlane32_swap(__float_as_uint(tot), __float_as_uint(tot), false, false); tot = __uint_as_float(rr[0]) + __uint_as_float(rr[1]); }
    __syncthreads();
    if (hi == 0) wsf[r32] = tot;
    __syncthreads();
    { const float ta = tot + wsp[r32]; if (hi == 0) wsf[64 + r32] = __builtin_amdgcn_rsqf(ta * (1.f / 256.f) + 1e-6f) * post; asm volatile("s_waitcnt lgkmcnt(0)" ::: "memory"); }
    float gv[4];
#pragma unroll
    for (int d0 = 0; d0 < 4; ++d0) gv[d0] = gain[kh * 128 + d0 * 32 + r32];
    char* Owb = (char*)Ob + ((size_t)(rg * QBLK) * LDO + (size_t)kh * 128) * 2u; asm volatile("" : "+s"(Owb));
    unsigned lo = ((unsigned)(4 * hi) * LDO + (unsigned)r32) * 2u; asm volatile("" : "+v"(lo));
#pragma unroll
    for (int r = 0; r < 16; ++r) { const float rs = wsf[64 + crow(r, hi)];
#pragma unroll
      for (int d0 = 0; d0 < 4; ++d0) { const unsigned off = lo + (unsigned)(((r & 3) + 8 * (r >> 2)) * LDO + d0 * 32) * 2u;
        *(__attribute__((address_space(1))) bf16_t*)((__attribute__((address_space(1))) char*)Owb + off) = (bf16_t)(cvtpk(o[d0][r] * rs * gv[d0], 0.f) & 0xffffu); } }
  }
  __syncthreads();
#undef KS_SLOADK
#undef KS_SLOADV
#undef KS_SWRITEK
#undef KS_SWRITEV
#undef KS_RESC
#undef KS_QKT
#undef KS_PMAX
#undef KS_SOFTMAX
#undef KS_PVD
#undef KS_PV
}

constexpr size_t K1_V = 0, K1_K = 65536, K1_X = 98304, K1_W = 132096;
template <int LDQ, int LDK, int LDO, int STAGE, unsigned VH2>
__device__ __forceinline__ void attn_ks1_body(const bf16_t* __restrict__ Qb, const bf16_t* __restrict__ Kh, const bf16_t* __restrict__ Vh, bf16_t* __restrict__ Ob, int seq, char* lds, const int wave_id,
                                              unsigned (&o0p)[4][8], const float lam, const float* __restrict__ gain, const float post) {
  int tid = wave_id * 64 + pg8::lane_now(); asm volatile("" : "+v"(tid));
  const int wid = __builtin_amdgcn_readfirstlane(tid >> 6), lane = tid & 63, r32 = lane & 31, hi = lane >> 5, rg = wid & 3, kh = wid >> 2;
  char* V_lds = lds + K1_V; char* K_lds = lds + K1_K;
  char* Xown = lds + K1_X + wid * 2048; char* Xpar = lds + K1_X + (wid ^ 4) * 2048;
  float* wsf = (float*)(lds + K1_W) + wid * 128; float* wsp = (float*)(lds + K1_W) + (wid ^ 4) * 128;
  float m_reg = -1e30f, l_reg = 0.f; f32x16 o[4] = {}; bf16x8 qr[8];
  { const bf16_t* Qw = Qb + (long)(rg * QBLK + r32) * LDQ + hi * 8;
#pragma unroll
    for (int d0 = 0; d0 < 8; ++d0) qr[d0] = *reinterpret_cast<const bf16x8*>(Qw + d0 * 16); }
  const int sr = tid >> 4, sc = (tid & 15) * 8;
  const int vrow = (wid << 2) | ((lane >> 5) << 1) | ((lane >> 2) & 1), vcol = ((lane >> 3) & 3) * 32 + (lane & 3) * 8, vst0 = v_st(vrow, vcol), vst1 = v_st(32 + vrow, vcol);
  const int vb_own = (int)(uintptr_t)V_lds + kh * 16384 + v_rd_base(lane) + kh * 8192;
  const int vb_par = (int)(uintptr_t)V_lds + kh * 16384 + v_rd_base(lane) + (kh ^ 1) * 8192;
  bf16x8 ks0, ks1, va0, va1, vb0_, vb1_;
  unsigned kvo0 = (unsigned)(sr * LDK + sc) * 2u, vvo0 = (unsigned)(vrow * LDK + vcol) * 2u; asm volatile("" : "+v"(kvo0), "+v"(vvo0));
#define K1_GLD(base, off) (*(const __attribute__((address_space(1))) bf16x8*)((const __attribute__((address_space(1))) char*)(base) + (off)))
#define K1_LOADK(k0) do { const char* kb__ = (const char*)Kh + (size_t)(k0) * LDK * 2; const char* kb2__ = kb__ + 32 * LDK * 2; asm volatile("" : "+s"(kb__), "+s"(kb2__), "+v"(kvo0)); ks0 = K1_GLD(kb__, kvo0); ks1 = K1_GLD(kb2__, kvo0); } while (0)
#define K1_LOADV(k0) do { const char* vb__ = (const char*)Vh + (size_t)(k0) * LDK * 2; const char* vc__ = vb__ + VH2; const char* vb2__ = vb__ + 32 * LDK * 2; const char* vc2__ = vc__ + 32 * LDK * 2; asm volatile("" : "+s"(vb__), "+s"(vc__), "+s"(vb2__), "+s"(vc2__), "+v"(vvo0)); va0 = K1_GLD(vb__, vvo0); va1 = K1_GLD(vb2__, vvo0); vb0_ = K1_GLD(vc__, vvo0); vb1_ = K1_GLD(vc2__, vvo0); } while (0)
#define K1_WRITEK(b) do { const int kc = sc * 2; *(bf16x8*)(K_lds + (b) * 16384 + KSWZ(sr, kc)) = ks0; *(bf16x8*)(K_lds + (b) * 16384 + KSWZ(32 + sr, kc)) = ks1; } while (0)
#define K1_WRITEV(b) do { *(bf16x8*)(V_lds + (b) * 32768 + vst0) = va0; *(bf16x8*)(V_lds + (b) * 32768 + vst1) = va1; \
    *(bf16x8*)(V_lds + (b) * 32768 + 16384 + vst0) = vb0_; *(bf16x8*)(V_lds + (b) * 32768 + 16384 + vst1) = vb1_; } while (0)
#define K1_QKT(P, b) do { P = f32x16{}; const char* kb_ = K_lds + (b) * 16384; \
    _Pragma("unroll") for (int d0 = 0; d0 < 8; ++d0) { const int cb = (d0 * 16 + hi * 8) * 2; \
      const bf16x8 bq = *reinterpret_cast<const bf16x8*>(kb_ + KSWZ(32 * kh + r32, cb)); P = __builtin_amdgcn_mfma_f32_32x32x16_bf16(bq, qr[d0], P, 0, 0, 0); } } while (0)
#define K1_PMAX(P, PM, par_) do { float pm_ = P[0]; _Pragma("unroll") for (int r = 1; r < 16; ++r) pm_ = fmaxf(pm_, P[r]); \
    { auto rr = __builtin_amdgcn_permlane32_swap(__float_as_uint(pm_), __float_as_uint(pm_), false, false); pm_ = fmaxf(__uint_as_float(rr[0]), __uint_as_float(rr[1])); } \
    PM = pm_; if (hi == 0) wsf[32 * (par_) + r32] = pm_; } while (0)
#define K1_SOFTMAX(P, PMO, PMP, par_) do { constexpr float C = SCALE * 1.4426950408889634f; \
    const float pmax = fmaxf((PMO), (PMP)); float mn; \
    if (__builtin_expect(__all(pmax - m_reg <= THR / SCALE), 1)) { mn = m_reg; alpha = 1.f; } \
    else { mn = fmaxf(m_reg, pmax); alpha = __builtin_amdgcn_exp2f((m_reg - mn) * C); m_reg = mn; } \
    const float mnC = -mn * C; \
    _Pragma("unroll") for (int r = 0; r < 16; ++r) P[r] = __builtin_amdgcn_exp2f(fmaf(P[r], C, mnC)); \
    float ps = 0.f; _Pragma("unroll") for (int r = 0; r < 16; ++r) ps += P[r]; \
    { auto rr = __builtin_amdgcn_permlane32_swap(__float_as_uint(ps), __float_as_uint(ps), false, false); ps = __uint_as_float(rr[0]) + __uint_as_float(rr[1]); } \
    l_reg = l_reg * alpha + ps; \
    { unsigned a0 = cvtpk(P[0], P[1]), a1 = cvtpk(P[2], P[3]), b0 = cvtpk(P[4], P[5]), b1 = cvtpk(P[6], P[7]); \
      auto r0 = __builtin_amdgcn_permlane32_swap(a0, b0, false, false); auto r1 = __builtin_amdgcn_permlane32_swap(a1, b1, false, false); u32x4 w = {r0[0], r1[0], r0[1], r1[1]}; nown0 = *reinterpret_cast<bf16x8*>(&w); } \
    { unsigned a0 = cvtpk(P[8], P[9]), a1 = cvtpk(P[10], P[11]), b0 = cvtpk(P[12], P[13]), b1 = cvtpk(P[14], P[15]); \
      auto r0 = __builtin_amdgcn_permlane32_swap(a0, b0, false, false); auto r1 = __builtin_amdgcn_permlane32_swap(a1, b1, false, false); u32x4 w = {r0[0], r1[0], r0[1], r1[1]}; nown1 = *reinterpret_cast<bf16x8*>(&w); } \
    *(bf16x8*)(Xown + (par_) * 16384 + lane * 16) = nown0; *(bf16x8*)(Xown + (par_) * 16384 + 1024 + lane * 16) = nown1; } while (0)
#define K1_RESC() do { if (__any(alpha < 1.f)) { if (hi == 0) wsf[64 + r32] = alpha; asm volatile("s_waitcnt lgkmcnt(0)" ::: "memory"); \
      _Pragma("unroll") for (int d = 0; d < 4; ++d) _Pragma("unroll") for (int r = 0; r < 16; ++r) o[d][r] *= wsf[64 + crow(r, hi)]; } } while (0)
#define K1_PVD(D0, b) do { const int o_ = vb_own + (b) * 32768, p_ = vb_par + (b) * 32768; \
    const s16x4 l0 = tr_read<v_rd_off(D0, 0, 0)>(o_), h0 = tr_read<v_rd_off(D0, 0, 1)>(o_), l1 = tr_read<v_rd_off(D0, 1, 0)>(o_), h1 = tr_read<v_rd_off(D0, 1, 1)>(o_); \
    const s16x4 l2 = tr_read<v_rd_off(D0, 0, 0)>(p_), h2 = tr_read<v_rd_off(D0, 0, 1)>(p_), l3 = tr_read<v_rd_off(D0, 1, 0)>(p_), h3 = tr_read<v_rd_off(D0, 1, 1)>(p_); \
    asm volatile("s_waitcnt lgkmcnt(0)" ::: "memory"); SBAR(); \
    o[D0] = __builtin_amdgcn_mfma_f32_32x32x16_bf16(own0, ((bf16x8){l0[0], l0[1], l0[2], l0[3], h0[0], h0[1], h0[2], h0[3]}), o[D0], 0, 0, 0); \
    o[D0] = __builtin_amdgcn_mfma_f32_32x32x16_bf16(own1, ((bf16x8){l1[0], l1[1], l1[2], l1[3], h1[0], h1[1], h1[2], h1[3]}), o[D0], 0, 0, 0); \
    o[D0] = __builtin_amdgcn_mfma_f32_32x32x16_bf16(par0, ((bf16x8){l2[0], l2[1], l2[2], l2[3], h2[0], h2[1], h2[2], h2[3]}), o[D0], 0, 0, 0); \
    o[D0] = __builtin_amdgcn_mfma_f32_32x32x16_bf16(par1, ((bf16x8){l3[0], l3[1], l3[2], l3[3], h3[0], h3[1], h3[2], h3[3]}), o[D0], 0, 0, 0); } while (0)
  f32x16 S1, S2; float pm1 = 0.f, pm2 = 0.f, alpha = 1.f; bf16x8 own0, own1, par0, par1, nown0, nown1; const int NT = seq / KVBLK;
  K1_LOADK(0); K1_LOADV(0); asm volatile("s_waitcnt vmcnt(0)" ::: "memory"); K1_WRITEK(0); K1_WRITEV(0); K1_LOADK(KVBLK);
  __syncthreads();
  K1_QKT(S1, 0); K1_PMAX(S1, pm1, 0); K1_WRITEK(1); K1_LOADK(2 * KVBLK); K1_LOADV(KVBLK);
  __syncthreads();
  { const float pmp = wsp[32 * 0 + r32]; K1_SOFTMAX(S1, pm1, pmp, 0); K1_RESC(); own0 = nown0; own1 = nown1; }
  K1_QKT(S1, 1); K1_PMAX(S1, pm1, 1); K1_WRITEK(0); K1_LOADK(3 * KVBLK);
  __syncthreads();
  if (wid >= 4) __builtin_amdgcn_s_setprio(1);
#define K1_SEG(t, p, q) do { \
    par0 = *(const bf16x8*)(Xpar + p * 16384 + lane * 16); par1 = *(const bf16x8*)(Xpar + p * 16384 + 1024 + lane * 16); \
    const float pmp = wsp[32 * q + r32]; \
    if (t + 1 < NT) K1_WRITEV(q); \
    if (t + 3 < NT) K1_WRITEK(q); \
    if (t + 2 < NT) K1_LOADV((t + 2) * KVBLK); \
    if (t + 4 < NT) K1_LOADK((t + 4) * KVBLK); \
    K1_PVD(0, p); K1_PVD(1, p); K1_PVD(2, p); K1_PVD(3, p); \
    if (t + 1 < NT) { K1_SOFTMAX(S1, pm1, pmp, q); } else alpha = 1.f; \
    SBAR(); \
    if (t + 2 < NT) { K1_QKT(S2, p); K1_PMAX(S2, pm2, p); } \
    K1_RESC(); own0 = nown0; own1 = nown1; S1 = S2; pm1 = pm2; \
    __syncthreads(); \
  } while (0)
  for (int t = 0; t < NT; t += 2) { K1_SEG(t, 0, 1); K1_SEG(t + 1, 1, 0); }
#undef K1_SEG
  __builtin_amdgcn_s_setprio(0);
  if (hi == 0) wsf[96 + r32] = l_reg;
  __syncthreads();
  { const float lt = l_reg + wsp[96 + r32]; asm volatile("s_waitcnt lgkmcnt(0)" ::: "memory"); __syncthreads(); if (hi == 0) wsf[96 + r32] = lt; asm volatile("s_waitcnt lgkmcnt(0)" ::: "memory"); }
  float rli[16];
#pragma unroll
  for (int r = 0; r < 16; ++r) rli[r] = __builtin_amdgcn_rcpf(wsf[96 + crow(r, hi)]);
  if constexpr (STAGE == 0) {
#pragma unroll
    for (int d0 = 0; d0 < 4; ++d0)
#pragma unroll
      for (int i = 0; i < 8; ++i) o0p[d0][i] = cvtpk(o[d0][2 * i] * rli[2 * i], o[d0][2 * i + 1] * rli[2 * i + 1]);
  } else {
    float ssq[16];
#pragma unroll
    for (int r = 0; r < 16; ++r) ssq[r] = 0.f;
#pragma unroll
    for (int d0 = 0; d0 < 4; ++d0)
#pragma unroll
      for (int i = 0; i < 8; ++i) { const unsigned w = o0p[d0][i];
        const float da = __uint_as_float(w << 16) - lam * (o[d0][2 * i] * rli[2 * i]), db = __uint_as_float(w & 0xffff0000u) - lam * (o[d0][2 * i + 1] * rli[2 * i + 1]);
        o[d0][2 * i] = da; o[d0][2 * i + 1] = db; ssq[2 * i] += da * da; ssq[2 * i + 1] += db * db; }
    float* T = (float*)(K_lds + wid * 4096);
#pragma unroll
    for (int r = 0; r < 16; ++r) T[crow(r, hi) * 32 + r32] = ssq[r];
    asm volatile("s_waitcnt lgkmcnt(0)" ::: "memory");
    float tot = 0.f;
    { const f32x4* tp = (const f32x4*)(T + r32 * 32 + 16 * hi);
#pragma unroll
      for (int qq = 0; qq < 4; ++qq) { const f32x4 v = tp[qq]; tot += (v[0] + v[1]) + (v[2] + v[3]); } }
    { auto rr = __builtin_amdgcn_permlane32_swap(__float_as_uint(tot), __float_as_uint(tot), false, false); tot = __uint_as_float(rr[0]) + __uint_as_float(rr[1]); }
    if (hi == 0) wsf[r32] = tot;
    __syncthreads();
    { const float ta = tot + wsp[r32]; if (hi == 0) wsf[64 + r32] = __builtin_amdgcn_rsqf(ta * (1.f / 256.f) + 1e-6f) * post; asm volatile("s_waitcnt lgkmcnt(0)" ::: "memory"); }
    float gv[4];
#pragma unroll
    for (int d0 = 0; d0 < 4; ++d0) gv[d0] = gain[kh * 128 + d0 * 32 + r32];
    char* Owb = (char*)Ob + ((size_t)(rg * QBLK) * LDO + (size_t)kh * 128) * 2u; asm volatile("" : "+s"(Owb));
    unsigned lo = ((unsigned)(4 * hi) * LDO + (unsigned)r32) * 2u; asm volatile("" : "+v"(lo));
#pragma unroll
    for (int r = 0; r < 16; ++r) { const float rs = wsf[64 + crow(r, hi)];
#pragma unroll
      for (int d0 = 0; d0 < 4; ++d0) { const unsigned off = lo + (unsigned)(((r & 3) + 8 * (r >> 2)) * LDO + d0 * 32) * 2u;
        *(__attribute__((address_space(1))) bf16_t*)((__attribute__((address_space(1))) char*)Owb + off) = (bf16_t)(cvtpk(o[d0][r] * rs * gv[d0], 0.f) & 0xffffu); } }
  }
  __syncthreads();
#undef K1_GLD
#undef K1_LOADK
#undef K1_LOADV
#undef K1_WRITEK
#undef K1_WRITEV
#undef K1_QKT
#undef K1_PMAX
#undef K1_SOFTMAX
#undef K1_RESC
#undef K1_PVD
}
#undef KSWZ
#undef SBAR
}
constexpr int NWAVES = 8;
constexpr int DM = 4096, NB = 2, SEQ = 4096, M = NB * SEQ, NH = 16, MEMT = 256, XW = 512, DFF = 16384;
constexpr float EPS = 1e-6f;
constexpr float LAM_INIT0 = 0.2f;

constexpr size_t MiB = 1u << 20;
constexpr size_t WS_CTL = 0, CTL_ZERO_BYTES = 1 * MiB;
constexpr size_t WS_WQKV = 1 * MiB;
constexpr size_t WS_WO   = WS_WQKV + 96 * MiB;
constexpr size_t WS_WIN  = WS_WO + 32 * MiB;
constexpr size_t WS_WG   = WS_WIN + 64 * MiB;
constexpr size_t WS_WOUT = WS_WG + 8 * MiB;
constexpr size_t WS_WXQ  = WS_WOUT + 32 * MiB;
constexpr size_t WS_WXKV = WS_WXQ + 8 * MiB;
constexpr size_t WS_WXO  = WS_WXKV + 16 * MiB;
constexpr size_t WS_W1   = WS_WXO + 8 * MiB;
constexpr size_t WS_W2   = WS_W1 + 256 * MiB;
constexpr size_t WS_H    = WS_W2 + 256 * MiB;
constexpr size_t WS_XN   = WS_H + 128 * MiB;
constexpr size_t WS_QKV  = WS_XN + 64 * MiB;
constexpr size_t WS_R256 = WS_QKV + 192 * MiB;
constexpr size_t WS_ON   = WS_R256 + 256 * MiB;
constexpr size_t WS_Y    = WS_ON + 64 * MiB;
constexpr size_t WS_SLAB = WS_Y + 64 * MiB;
constexpr size_t WS_OX   = WS_SLAB + 64 * MiB;
constexpr size_t WS_KV   = WS_OX + 8 * MiB;
constexpr size_t WS_MEMN = WS_KV + 2 * MiB;
constexpr size_t WS_ROPE = WS_MEMN + 8 * MiB;
constexpr size_t WS_SP8  = WS_ROPE + 1 * MiB;
constexpr size_t WS_AGG  = WS_SP8 + 1 * MiB;
constexpr size_t WS_CARRY = WS_AGG + 8 * MiB;
constexpr size_t WS_END  = WS_CARRY + 4 * MiB;
static_assert(WS_END <= 1720 * MiB, "d_ws map");

constexpr int CW_BAR = 4096;
constexpr int RING_BYTES = 131072, LDSCTL_OFF = RING_BYTES, MISC_OFF = LDSCTL_OFF + 320, LDS_BYTES = 147456;

#define GAS __attribute__((address_space(1)))
#define LAS __attribute__((address_space(3)))
typedef unsigned short bf16;
typedef unsigned v4u __attribute__((ext_vector_type(4)));
typedef unsigned v2u __attribute__((ext_vector_type(2)));
typedef float f32x4 __attribute__((ext_vector_type(4)));
typedef float f32x2 __attribute__((ext_vector_type(2)));
#define LDS_WAIT() asm volatile("s_waitcnt lgkmcnt(0)" ::: "memory")
#define VM_WAIT() asm volatile("s_waitcnt vmcnt(0)" ::: "memory")
__device__ __forceinline__ unsigned pk2(float lo, float hi) { return pg8::cvt_pk_bf16(lo, hi); }
using pg8::bf_lo; using pg8::bf_hi;

#define XB_TMO      128
#define XB_XCNT(j)  (256  + 64 * (j))
#define XB_XSUB(j)  (1280 + 64 * (j))
#define XB_XGEN(j)  (2304 + 64 * (j))
#define XB_TOP      3328
#define XB_TOPGEN   3392
#define XCD_BAR_WORDS 3456
#define XB_SPIN_CAP (1u << 22)
__device__ __forceinline__ unsigned xb_ld(unsigned* p)              { return __hip_atomic_load(p, __ATOMIC_RELAXED, __HIP_MEMORY_SCOPE_AGENT); }
__device__ __forceinline__ unsigned xb_add(unsigned* p, unsigned v) { return __hip_atomic_fetch_add(p, v, __ATOMIC_RELAXED, __HIP_MEMORY_SCOPE_AGENT); }
__device__ __forceinline__ unsigned xb_xcc_id() { return (unsigned)__builtin_amdgcn_s_getreg((3 << 11) | 20) & 0xFu; }
#define XB_SPIN(cond, bar) do { unsigned _sp = 0; while (cond) { __builtin_amdgcn_s_sleep(1); \
    if ((++_sp & 255u) == 0u) { if (xb_ld(&(bar)[XB_TMO])) break; if (_sp > XB_SPIN_CAP) { atomicAdd(&(bar)[XB_TMO], 1u); break; } } } } while (0)
struct XcdBarrier { unsigned* bar; unsigned x; volatile LAS unsigned* st; };
__device__ __forceinline__ XcdBarrier xcd_barrier_post(unsigned* bar, volatile LAS unsigned* st) {
    XcdBarrier b; b.bar = bar; b.x = xb_xcc_id(); b.st = st;
    if (threadIdx.x == 0) (void)xb_add(&bar[XB_XCNT(b.x)], 1u);
    return b;
}
__device__ __forceinline__ void xcd_barrier_complete(unsigned* bar, unsigned x, unsigned& nloc, unsigned& nx) {
    const unsigned G = gridDim.x * gridDim.y * gridDim.z;
    unsigned sum, cnt, mine, sp = 0u;
    for (;;) {
        sum = 0u; cnt = 0u; mine = 0u;
#pragma unroll
        for (unsigned j = 0; j < 16; ++j) { const unsigned c = xb_ld(&bar[XB_XCNT(j)]); sum += c; cnt += (c > 0u) ? 1u : 0u; mine = (j == x) ? c : mine; }
        if (sum == G) break;
        __builtin_amdgcn_s_sleep(1);
        if ((++sp & 255u) == 0u) { if (xb_ld(&bar[XB_TMO])) break; if (sp > XB_SPIN_CAP) { atomicAdd(&bar[XB_TMO], 1u); break; } }
    }
    nloc = mine > 0u ? mine : 1u; nx = cnt > 0u ? cnt : 1u;
}
__device__ __forceinline__ void xcd_barrier_impl(unsigned* bar_, unsigned x_, volatile LAS unsigned* st_, int wave_id_) {
    XcdBarrier b; b.bar = bar_; b.x = x_; b.st = st_;
    asm volatile("s_waitcnt vmcnt(0)" ::: "memory");
    __syncthreads();
    int t0_ = wave_id_ * 64 + pg8::lane_now(); asm volatile("" : "+v"(t0_));
    { unsigned xo = b.x; asm volatile("" : "+s"(xo)); b.x = xo; }
    if (t0_ == 0) {
        unsigned* bar = b.bar; asm volatile("" : "+s"(bar));
        __builtin_amdgcn_s_waitcnt(0);
        unsigned nloc = b.st[0], nx = b.st[1];
        if (nloc == 0u) { xcd_barrier_complete(bar, b.x, nloc, nx); b.st[0] = nloc; b.st[1] = nx; }
        const unsigned old = xb_add(&bar[XB_XSUB(b.x)], 1u);
        const unsigned gen = old / nloc;
        if (old + 1u == (gen + 1u) * nloc) {
            __builtin_amdgcn_fence(__ATOMIC_RELEASE, "agent");
            asm volatile("s_waitcnt vmcnt(0)" ::: "memory");
            const unsigned og = xb_add(&bar[XB_TOP], 1u);
            const unsigned tg = og / nx;
            if (og + 1u == (tg + 1u) * nx) xb_add(&bar[XB_TOPGEN], 1u);
            else XB_SPIN(xb_ld(&bar[XB_TOPGEN]) == tg, bar);
            __builtin_amdgcn_fence(__ATOMIC_ACQUIRE, "agent");
            xb_add(&bar[XB_XGEN(b.x)], 1u);
            asm volatile("s_waitcnt vmcnt(0)" ::: "memory");
        } else {
            XB_SPIN(xb_ld(&bar[XB_XGEN(b.x)]) == gen, bar);
            __builtin_amdgcn_fence(__ATOMIC_ACQUIRE, "agent");
            asm volatile("s_waitcnt vmcnt(0)" ::: "memory");
        }
    }
    __syncthreads();
}
__device__ __forceinline__ void xcd_barrier(const XcdBarrier& b, int wave_id) { xcd_barrier_impl(b.bar, b.x, b.st, wave_id); }

struct Frame {
    LAS unsigned char* lds;
    int tid, lane, wave, vcu, G;
    int gw, NGW;
};

__device__ __forceinline__ float wave_sum(float v, int lane) {
#pragma unroll
    for (int o = 1; o < 64; o <<= 1) v += __builtin_bit_cast(float, __builtin_amdgcn_ds_bpermute((lane ^ o) << 2, __builtin_bit_cast(int, v)));
    return v;
}

__device__ __forceinline__ void sincos_d(float ang, float& s, float& c) {
    const double x = (double)ang;
    const double n = rint(x * 0.15915494309189535);
    double r = x - n * 6.283185307179586;
    const double k = rint(r * 0.6366197723675814);
    const double t = r - k * 1.5707963267948966;
    const double t2 = t * t;
    double sp = -7.6471637318198164e-13;
    sp = sp * t2 + 1.6059043836821613e-10; sp = sp * t2 - 2.5052108385441720e-08; sp = sp * t2 + 2.7557319223985893e-06;
    sp = sp * t2 - 1.9841269841269841e-04; sp = sp * t2 + 8.3333333333333332e-03; sp = sp * t2 - 1.6666666666666666e-01;
    const double st = t + t * t2 * sp;
    double cp = 4.7794773323873853e-14;
    cp = cp * t2 - 1.1470745597729725e-11; cp = cp * t2 + 2.0876756987868100e-09; cp = cp * t2 - 2.7557319223985888e-07;
    cp = cp * t2 + 2.4801587301587302e-05; cp = cp * t2 - 1.3888888888888889e-03; cp = cp * t2 + 4.1666666666666664e-02; cp = cp * t2 - 0.5;
    const double ct = 1.0 + t2 * cp;
    const int ki = ((int)k) & 3;
    double so, co;
    if (ki == 0) { so = st; co = ct; } else if (ki == 1) { so = ct; co = -st; } else if (ki == 2) { so = -st; co = -ct; } else { so = -ct; co = st; }
    s = (float)so; c = (float)co;
}
__constant__ float c_inv_freq[16] = {1.000000000e+00f, 4.403665960e-01f, 1.939227432e-01f, 8.539710194e-02f, 3.760603070e-02f, 1.656043902e-02f, 7.292664610e-03f, 3.211445874e-03f,
                                     1.414213562e-03f, 6.227723788e-04f, 2.742481884e-04f, 1.207697351e-04f, 5.318296098e-05f, 2.341999971e-05f, 1.031338616e-05f, 4.541670478e-06f};

struct ConvJob { const float* src; bf16* dst; const float* gain; int K, N, ldd, mode, aux; };
struct ConvRegs { f32x4 v[16]; };
__device__ __forceinline__ void conv_load(const ConvJob& J, int item, int lane, ConvRegs& R) {
    const int nblk = J.N >> 6, kb = item / nblk, nb = item - kb * nblk, k0 = kb << 6, n0 = nb << 6;
    const int q = lane >> 4, l = lane & 15;
    const float* sp = J.src + (size_t)(k0 + 16 * q) * J.N + n0 + 4 * l;
#pragma unroll
    for (int r = 0; r < 16; ++r) R.v[r] = __builtin_nontemporal_load((const f32x4*)(sp + (size_t)r * J.N));
}
__device__ __forceinline__ void conv_finish(const ConvJob& J, int item, LAS unsigned* scr, int lane, ConvRegs& R) {
    const int nblk = J.N >> 6, kb = item / nblk, nb = item - kb * nblk, k0 = kb << 6, n0 = nb << 6;
    const int q = lane >> 4, l = lane & 15;
    if (J.gain) { const f32x4* gp = (const f32x4*)(J.gain + k0 + 16 * q);
#pragma unroll
        for (int r4 = 0; r4 < 4; ++r4) { const f32x4 g = gp[r4];
#pragma unroll
            for (int rr = 0; rr < 4; ++rr) R.v[4 * r4 + rr] *= g[rr]; } }
    LAS unsigned char* sb = (LAS unsigned char*)scr;
#pragma unroll
    for (int j = 0; j < 4; ++j) { const int n = 4 * l + j;
#pragma unroll
        for (int c = 0; c < 2; ++c) { v4u w;
#pragma unroll
            for (int e = 0; e < 4; ++e) w[e] = pk2(R.v[8 * c + 2 * e][j], R.v[8 * c + 2 * e + 1][j]);
            *(LAS v4u*)(sb + n * 128 + (((2 * q + c) ^ (l & 7)) << 4)) = w; } }
    LDS_WAIT(); asm volatile("" ::: "memory");
    const int c = lane & 7;
#pragma unroll
    for (int j = 0; j < 8; ++j) { const int n = (lane >> 3) + 8 * j;
        const v4u o = *(const LAS v4u*)(sb + n * 128 + ((c ^ ((n >> 2) & 7)) << 4));
        size_t drow, dcol;
        if (J.mode == 0) { drow = (size_t)(n0 + n); dcol = (size_t)k0 + 8 * c; }
        else { const int d = n0 + n, nbk = k0 >> 8; drow = (size_t)(((J.aux >> 1) * 16 + nbk) * 2 + (d >> 7)) * 256 + (J.aux & 1) * 128 + (d & 127); dcol = (size_t)(k0 & 255) + 8 * c; }
        __builtin_nontemporal_store(o, (GAS v4u*)(J.dst + drow * J.ldd + dcol)); }
    LDS_WAIT(); asm volatile("" ::: "memory");
}

template <bool OUT_F32>
__device__ __forceinline__ void rms_row(const float* xrow, const float* g, void* orow, int lane) {
    const GAS f32x4* xr = (const GAS f32x4*)xrow + lane; const GAS f32x4* gr = (const GAS f32x4*)g + lane;
    f32x4 v[16]; float s = 0.f;
#pragma unroll
    for (int j = 0; j < 16; ++j) { v[j] = xr[64 * j]; s += (v[j].x * v[j].x + v[j].y * v[j].y) + (v[j].z * v[j].z + v[j].w * v[j].w); }
    const float r = __builtin_amdgcn_rsqf(wave_sum(s, lane) * (1.f / DM) + EPS);
#pragma unroll
    for (int j = 0; j < 16; ++j) { const f32x4 gg = gr[64 * j]; const f32x4 o = v[j] * r * gg;
        if (OUT_F32) ((GAS f32x4*)orow + lane)[64 * j] = o;
        else { v2u w; w.x = pk2(o.x, o.y); w.y = pk2(o.z, o.w); ((GAS v2u*)orow + lane)[64 * j] = w; } }
}
__device__ __forceinline__ void rms_row_bf16_in(const bf16* xrow, const float* g, float* orow, int lane) {
    const GAS v4u* xr = (const GAS v4u*)xrow + lane; const GAS f32x4* gr = (const GAS f32x4*)g + 2 * lane;
    v4u w[8]; float s = 0.f;
#pragma unroll
    for (int j = 0; j < 8; ++j) { w[j] = xr[64 * j];
#pragma unroll
        for (int q = 0; q < 4; ++q) { const float a = bf_lo(w[j][q]), b = bf_hi(w[j][q]); s += a * a + b * b; } }
    const float r = __builtin_amdgcn_rsqf(wave_sum(s, lane) * (1.f / DM) + EPS);
#pragma unroll
    for (int j = 0; j < 8; ++j) { const f32x4 g0 = gr[128 * j], g1 = gr[128 * j + 1];
        const f32x4 o0 = (f32x4){bf_lo(w[j].x), bf_hi(w[j].x), bf_lo(w[j].y), bf_hi(w[j].y)} * r * g0, o1 = (f32x4){bf_lo(w[j].z), bf_hi(w[j].z), bf_lo(w[j].w), bf_hi(w[j].w)} * r * g1;
        GAS f32x4* op = (GAS f32x4*)orow + 2 * lane + 128 * j; op[0] = o0; op[1] = o1; }
}
template <bool OUT_F32>
__device__ __forceinline__ void rms_phase(const Frame& F, const float* src, const float* g, void* dst, int rows) {
    for (int m = F.gw; m < rows; m += F.NGW) rms_row<OUT_F32>(src + (size_t)m * DM, g, OUT_F32 ? (void*)((float*)dst + (size_t)m * DM) : (void*)((bf16*)dst + (size_t)m * DM), F.lane);
}
constexpr int CW_ROWSS = 131072;
struct Args { const float* in[35]; float* out; unsigned char* ws; int ph_lo, ph_hi; };
#define KAS __attribute__((address_space(4)))
__device__ __forceinline__ const float* arg_in(int k) { int o = k * 8; asm volatile("" : "+s"(o)); return *(const float* const KAS*)((const KAS char*)__builtin_amdgcn_kernarg_segment_ptr() + o); }
__device__ __forceinline__ float* arg_out() { int o = 280; asm volatile("" : "+s"(o)); return *(float* const KAS*)((const KAS char*)__builtin_amdgcn_kernarg_segment_ptr() + o); }
__device__ __forceinline__ unsigned char* arg_ws() { int o = 288; asm volatile("" : "+s"(o)); return *(unsigned char* const KAS*)((const KAS char*)__builtin_amdgcn_kernarg_segment_ptr() + o); }
static_assert(offsetof(Args, out) == 280 && offsetof(Args, ws) == 288, "Args layout");

__device__ __forceinline__ bool p0_job(unsigned char* ws, int it, ConvJob& J, int& local) {
#define JOB(cnt, SRC, DST, KK, NN, LDD, MODE, AUX, GAIN) if (it < (cnt)) { J.src = (SRC); J.dst = (bf16*)(DST); J.gain = (GAIN); J.K = (KK); J.N = (NN); J.ldd = (LDD); J.mode = (MODE); J.aux = (AUX); local = it; return true; } it -= (cnt);
    JOB(12288, arg_in(4), ws + WS_WQKV, 4096, 12288, 4096, 0, 0, nullptr)
    JOB(1024, arg_in(29), ws + WS_WXKV, 4096, 1024, 4096, 0, 0, nullptr)
    JOB(1024, arg_in(29) + (size_t)4096 * 1024, ws + WS_WXKV + 8 * MiB, 4096, 1024, 4096, 0, 0, nullptr)
    JOB(4096, arg_in(10), ws + WS_WO, 4096, 4096, 4096, 0, 0, nullptr)
    JOB(8192, arg_in(12), ws + WS_WIN, 4096, 8192, 4096, 0, 0, arg_in(11))
    JOB(4096, arg_in(25), ws + WS_WOUT, 4096, 4096, 4096, 0, 0, nullptr)
    JOB(512, arg_in(28), ws + WS_WXQ, 4096, 512, 4096, 0, 0, arg_in(26))
    JOB(512, arg_in(28) + (size_t)4096 * 512, ws + WS_WXQ + 4 * MiB, 4096, 512, 4096, 0, 0, arg_in(26) + DM)
    JOB(512, arg_in(30), ws + WS_WXO, 512, 4096, 512, 0, 0, nullptr)
    JOB(512, arg_in(30) + (size_t)512 * 4096, ws + WS_WXO + 4 * MiB, 512, 4096, 512, 0, 0, nullptr)
    JOB(16384, arg_in(32), ws + WS_W1, 4096, 16384, 4096, 0, 0, arg_in(31))
    JOB(16384, arg_in(32) + (size_t)4096 * 16384, ws + WS_W1 + 128 * MiB, 4096, 16384, 4096, 0, 0, arg_in(31) + DM)
    JOB(16384, arg_in(33), ws + WS_W2, 16384, 4096, 16384, 0, 0, nullptr)
    JOB(16384, arg_in(33) + (size_t)16384 * 4096, ws + WS_W2 + 128 * MiB, 16384, 4096, 16384, 0, 0, nullptr)
    JOB(256, arg_in(15), ws + WS_WG, 4096, 256, 256, 1, 0, nullptr)
    JOB(256, arg_in(17), ws + WS_WG, 4096, 256, 256, 1, 1, nullptr)
    JOB(256, arg_in(20), ws + WS_WG, 4096, 256, 256, 1, 2, nullptr)
    JOB(256, arg_in(22), ws + WS_WG, 4096, 256, 256, 1, 3, nullptr)
#undef JOB
    return false;
}
constexpr int P0_NITEMS = 12288 + 4096 + 8192 + 4096 + 1024 + 2048 + 1024 + 32768 + 32768 + 1024;

__device__ __forceinline__ void p0_convert(const Frame& F, int it_lo, int it_hi, int gw, int ngw) {
    unsigned char* ws = arg_ws();
    LAS unsigned* scr = (LAS unsigned*)(F.lds + F.wave * 8192);
    for (int it = it_lo + gw; it < it_hi; it += 2 * ngw) {
        ConvJob J0, J1; int l0, l1; ConvRegs R0, R1;
        const int it1 = it + ngw; const bool h1 = it1 < it_hi;
        (void)p0_job(ws, it, J0, l0); (void)p0_job(ws, h1 ? it1 : it, J1, l1);
        conv_load(J0, l0, F.lane, R0);
        conv_load(J1, l1, F.lane, R1);
        conv_finish(J0, l0, scr, F.lane, R0);
        if (h1) conv_finish(J1, l1, scr, F.lane, R1);
    }
}
#ifndef QKV_NG
#define QKV_NG 192
#endif
#ifndef P0_FIRST
#define P0_FIRST 14336
#endif
constexpr int P0_FIRST_ITEMS = (QKV_NG < 256) ? P0_FIRST : P0_NITEMS;
__device__ __forceinline__ void p0_prologue(const Frame& F) {
    unsigned char* ws = arg_ws();
    p0_convert(F, 0, P0_FIRST_ITEMS, F.gw, F.NGW);
    { float* ct = (float*)(ws + WS_ROPE); float* st = ct + (size_t)M * 16; const int* pos = (const int*)arg_in(2);
      for (int e = F.gw * 64 + F.lane; e < M * 16; e += F.NGW * 64) { const int row = e >> 4, i = e & 15; float s, c; sincos_d((float)pos[row] * c_inv_freq[i], s, c); ct[e] = c; st[e] = s; } }
    { float* sp8 = (float*)(ws + WS_SP8);
      for (int e = F.gw * 64 + F.lane; e < 2 * DM; e += F.NGW * 64) { const float lam = (e < DM) ? arg_in(19)[e] : arg_in(24)[e - DM]; sp8[e] = 8.f * log1pf(expf(-lam)); } }
    rms_phase<false>(F, arg_in(0), arg_in(3), ws + WS_XN, M);
    rms_phase<false>(F, arg_in(1), arg_in(27), ws + WS_MEMN, NB * MEMT);
    rms_phase<false>(F, arg_in(1), arg_in(27) + DM, ws + WS_MEMN + 4 * MiB, NB * MEMT);
}

__device__ __forceinline__ void conv_phase(const Frame& F) {
    unsigned char* ws = arg_ws();
    const bf16* ug = (const bf16*)(ws + WS_QKV); bf16* uc = (bf16*)(ws + WS_ON);
    const float* cw = arg_in(13); const float* cb = arg_in(14);
    for (int it = F.gw; it < 8 * (M / 32); it += F.NGW) {
        const int g = it & 7, rc = it >> 3, c0 = g * 512 + 8 * F.lane, row0 = rc * 32, t0 = row0 & (SEQ - 1);
        float w[4][8], bb[8];
#pragma unroll
        for (int tap = 0; tap < 4; ++tap) { const f32x4 x0 = *(const f32x4*)(cw + tap * DM + c0), x1 = *(const f32x4*)(cw + tap * DM + c0 + 4);
            w[tap][0] = x0.x; w[tap][1] = x0.y; w[tap][2] = x0.z; w[tap][3] = x0.w; w[tap][4] = x1.x; w[tap][5] = x1.y; w[tap][6] = x1.z; w[tap][7] = x1.w; }
        { const f32x4 x0 = *(const f32x4*)(cb + c0), x1 = *(const f32x4*)(cb + c0 + 4); bb[0] = x0.x; bb[1] = x0.y; bb[2] = x0.z; bb[3] = x0.w; bb[4] = x1.x; bb[5] = x1.y; bb[6] = x1.z; bb[7] = x1.w; }
        v4u raw[35];
#pragma unroll
        for (int i = 0; i < 35; ++i) { const int t = t0 + i - 2; const bool ok = (t >= 0 && t < SEQ); const int rr = ok ? row0 + i - 2 : row0;
            const v4u x = *(const GAS v4u*)(ug + (size_t)rr * (2 * DM) + c0); const unsigned msk = ok ? 0xffffffffu : 0u; raw[i] = (v4u){x.x & msk, x.y & msk, x.z & msk, x.w & msk}; }
#pragma unroll
        for (int i = 0; i < 32; ++i) { float o[8];
#pragma unroll
            for (int j = 0; j < 8; ++j) o[j] = bb[j];
#pragma unroll
            for (int tap = 0; tap < 4; ++tap) { const v4u r = raw[i + tap];
#pragma unroll
                for (int q = 0; q < 4; ++q) { o[2 * q] = fmaf(bf_lo(r[q]), w[tap][2 * q], o[2 * q]); o[2 * q + 1] = fmaf(bf_hi(r[q]), w[tap][2 * q + 1], o[2 * q + 1]); } }
            v4u ov; ov.x = pk2(o[0], o[1]); ov.y = pk2(o[2], o[3]); ov.z = pk2(o[4], o[5]); ov.w = pk2(o[6], o[7]);
            *(GAS v4u*)(uc + (size_t)(row0 + i) * DM + c0) = ov; }
    }
}

constexpr float L2E = 1.4426950408889634f;
__device__ __forceinline__ void scan_agg_phase(const Frame& F) {
    unsigned char* ws = arg_ws();
    const unsigned* G = (const unsigned*)(ws + WS_R256); float* aggA = (float*)(ws + WS_AGG); float* aggH = aggA + (size_t)2 * 2 * 64 * DM;
    for (int it = F.gw; it < 4096; it += F.NGW) {
        const int cg = it & 15, k = (it >> 4) & 63, b = (it >> 10) & 1, dir = it >> 11, ch = cg * 256 + 4 * F.lane;
        const unsigned* gp = G + (size_t)dir * ((size_t)M * DM) + (size_t)(b * SEQ + k * 64) * DM + ch;
        f32x4 sla = {0.f, 0.f, 0.f, 0.f}, H = {0.f, 0.f, 0.f, 0.f};
#pragma unroll 16
        for (int s = 0; s < 64; ++s) { const int t = dir ? 63 - s : s; const v4u w = *(const GAS v4u*)(gp + (size_t)t * DM);
#pragma unroll
            for (int j = 0; j < 4; ++j) { const float la = bf_lo(w[j]), inp = bf_hi(w[j]); H[j] = fmaf(__builtin_amdgcn_exp2f(la * L2E), H[j], inp); sla[j] += la; } }
        const size_t o = (size_t)((dir * 2 + b) * 64 + k) * DM + ch;
        *(GAS f32x4*)(aggA + o) = sla; *(GAS f32x4*)(aggH + o) = H;
    }
}
__device__ __forceinline__ void scan_carry_phase(const Frame& F) {
    unsigned char* ws = arg_ws();
    const float* aggA = (const float*)(ws + WS_AGG); const float* aggH = aggA + (size_t)2 * 2 * 64 * DM; float* carry = (float*)(ws + WS_CARRY);
    const int task = (int)blockIdx.x;
    if (task < 64 && F.wave == 0) {
        const int cg = task & 15, b = (task >> 4) & 1, dir = task >> 5, ch = cg * 256 + 4 * F.lane;
        f32x4 c = {0.f, 0.f, 0.f, 0.f};
#pragma unroll 16
        for (int s = 0; s < 64; ++s) { const int k = dir ? 63 - s : s; const size_t o = (size_t)((dir * 2 + b) * 64 + k) * DM + ch;
            const f32x4 A = *(const GAS f32x4*)(aggA + o), H = *(const GAS f32x4*)(aggH + o);
            *(GAS f32x4*)(carry + o) = c;
#pragma unroll
            for (int j = 0; j < 4; ++j) c[j] = fmaf(__builtin_amdgcn_exp2f(A[j] * L2E), c[j], H[j]); }
    }
}
__device__ __forceinline__ float gelu_tanh_f(float g) { const float u = 0.7978845608028654f * (g + 0.044715f * g * g * g); return g * __builtin_amdgcn_rcpf(1.f + __builtin_amdgcn_exp2f(-2.f * L2E * u)); }
__device__ __forceinline__ void scan_final_phase(const Frame& F) {
    unsigned char* ws = arg_ws();
    const unsigned* G = (const unsigned*)(ws + WS_R256); const float* carry = (const float*)(ws + WS_CARRY);
    const bf16* ug = (const bf16*)(ws + WS_QKV); bf16* Y = (bf16*)(ws + WS_Y);
    for (int it = F.gw; it < 2048; it += F.NGW) {
        const int cg = it & 15, k = (it >> 4) & 63, b = it >> 10, ch = cg * 256 + 4 * F.lane;
        const size_t rowbase = (size_t)(b * SEQ + k * 64);
        const unsigned* gf = G + rowbase * DM + ch; const unsigned* gb = gf + (size_t)M * DM;
        f32x4 h = *(const GAS f32x4*)(carry + (size_t)((0 * 2 + b) * 64 + k) * DM + ch);
        v2u hf[64];
#pragma unroll
        for (int tb = 0; tb < 64; tb += 16) { v4u w[16];
#pragma unroll
            for (int t = 0; t < 16; ++t) w[t] = *(const GAS v4u*)(gf + (size_t)(tb + t) * DM);
#pragma unroll
            for (int t = 0; t < 16; ++t) {
#pragma unroll
                for (int j = 0; j < 4; ++j) h[j] = fmaf(__builtin_amdgcn_exp2f(bf_lo(w[t][j]) * L2E), h[j], bf_hi(w[t][j]));
                hf[tb + t].x = pk2(h[0], h[1]); hf[tb + t].y = pk2(h[2], h[3]); }
            asm volatile("" ::: "memory"); }
        h = *(const GAS f32x4*)(carry + (size_t)((1 * 2 + b) * 64 + k) * DM + ch);
#pragma unroll
        for (int tb = 48; tb >= 0; tb -= 16) { v4u w[16]; v2u gw2[16];
#pragma unroll
            for (int t = 15; t >= 0; --t) { w[t] = *(const GAS v4u*)(gb + (size_t)(tb + t) * DM); gw2[t] = *(const GAS v2u*)(ug + (rowbase + tb + t) * (2 * DM) + DM + ch); }
#pragma unroll
            for (int t = 15; t >= 0; --t) {
#pragma unroll
                for (int j = 0; j < 4; ++j) h[j] = fmaf(__builtin_amdgcn_exp2f(bf_lo(w[t][j]) * L2E), h[j], bf_hi(w[t][j]));
                const v2u f = hf[tb + t];
                const float y0 = (bf_lo(f.x) + h[0]) * gelu_tanh_f(bf_lo(gw2[t].x)), y1 = (bf_hi(f.x) + h[1]) * gelu_tanh_f(bf_hi(gw2[t].x));
                const float y2 = (bf_lo(f.y) + h[2]) * gelu_tanh_f(bf_lo(gw2[t].y)), y3 = (bf_hi(f.y) + h[3]) * gelu_tanh_f(bf_hi(gw2[t].y));
                v2u o; o.x = pk2(y0, y1); o.y = pk2(y2, y3); *(GAS v2u*)(Y + (rowbase + tb + t) * DM + ch) = o; }
            asm volatile("" ::: "memory"); }
    }
}

struct SchedX1 {
    const char* xn; const char* wq; const char* memn; const char* wkv; int c; int mode;
    __device__ __forceinline__ bool next(int i, pg8::Unit& u) const {
        if (mode == 2) { if (c >= 16 || i > 0) return false; const int layer = c >> 3, pm = (c >> 2) & 1, pn = c & 3;
            u.A = memn + (size_t)layer * (4 * MiB) + (size_t)pm * 256 * 8192; u.B = wkv + (size_t)layer * (8 * MiB) + (size_t)pn * 256 * 8192; u.nt = 64; u.job = 1; u.aux = layer; u.pm = pm; u.pn = pn; return true; }
        const int q = c + i * 256;
        if (q >= 256) return false;
        const int ks = q & 3, pn = (q >> 2) & 1, pm = q >> 3;
        u.A = xn + (size_t)pm * 256 * 8192 + ks * 2048; u.B = wq + (size_t)pn * 256 * 8192 + ks * 2048; u.nt = 16; u.job = 0; u.aux = ks; u.pm = pm; u.pn = pn; return true;
    }
};
struct SchedGates {
    const char* uc; const char* wg; int vcu;
    __device__ __forceinline__ bool next(int i, pg8::Unit& u) const {
        if (i >= 8) return false;
        const int L = vcu * 8 + i, half = L & 1, dir = (L >> 1) & 1, grp = L >> 2, nb = grp & 15, pm = grp >> 4;
        u.A = uc + (size_t)pm * 256 * 8192 + nb * 512; u.B = wg + (size_t)(((dir * 16 + nb) * 2 + half) * 256) * 512; u.nt = 4; u.job = 0; u.aux = dir * 32 + nb * 2 + half + ((L & 3) == 3 ? 64 : 0); u.pm = pm; u.pn = 0; return true;
    }
};

#ifndef ATT_KS_BODY
#define ATT_KS_BODY attn_ks1_body
#endif
#ifndef ATT_SDEPTH
#define ATT_SDEPTH 1
#endif
__device__ __forceinline__ bool ph_in(int ph, int lo, int hi) { asm volatile("" : "+s"(ph)); return ph >= lo && ph < hi; }
__global__ void __launch_bounds__(NWAVES * 64, 2) mega_fwd(Args args) {
    extern __shared__ __attribute__((aligned(16))) unsigned char lds[];
    Frame F0;
    F0.lds = (LAS unsigned char*)lds;
    F0.tid = threadIdx.x; F0.lane = F0.tid & 63; F0.wave = __builtin_amdgcn_readfirstlane(F0.tid >> 6);
    F0.G = gridDim.x; { const int bx = blockIdx.x; F0.vcu = (F0.G % 8 == 0) ? (bx % 8) * (F0.G / 8) + bx / 8 : bx; }
    F0.gw = F0.vcu * NWAVES + F0.wave; F0.NGW = F0.G * NWAVES;
    volatile LAS unsigned* MISC = (volatile LAS unsigned*)(F0.lds + MISC_OFF);
    for (int u = F0.tid; u < (LDS_BYTES - LDSCTL_OFF) / 4; u += NWAVES * 64) ((LAS unsigned*)(F0.lds + LDSCTL_OFF))[u] = 0u;
    __syncthreads();
    const int lo = args.ph_lo, hi = args.ph_hi;
    XcdBarrier bar; bar.bar = (unsigned*)(args.ws + WS_CTL) + CW_BAR; bar.x = 0; bar.st = nullptr;
    if (hi - lo > 1) bar = xcd_barrier_post((unsigned*)(args.ws + WS_CTL) + CW_BAR, MISC + 8);
    int ph = 0;
#ifndef MK_PHMASK
#define MK_PHMASK 0xffffffffull
#endif
#ifndef MK_REPEAT
#define MK_REPEAT 0ull
#endif
#define PH_BEGIN(ID) if (((MK_PHMASK >> (ID)) & 1ull) != 0ull && ph_in(ph, lo, hi)) { unsigned char* ws = arg_ws(); pg8::bf16_t* h = (pg8::bf16_t*)(ws + WS_H); const char* xn = (const char*)(ws + WS_XN); const char* hA = (const char*)(ws + WS_H); (void)h; (void)xn; (void)hA; Frame F = F0; F.lane = pg8::lane_now(); F.tid = F.wave * 64 + F.lane; asm volatile("" : "+v"(F.lane), "+v"(F.tid), "+s"(F.gw), "+s"(F.vcu)); (void)F; constexpr int NREP = 1 + (int)((MK_REPEAT >> (ID)) & 1ull); for (int rep = 0; rep < NREP; ++rep) { const bool dummy = (rep + 1 < NREP); pg8::bf16_t* hout = dummy ? (pg8::bf16_t*)(ws + WS_QKV) : h; (void)hout; unsigned long long* RS = (unsigned long long*)((unsigned*)(ws + WS_CTL) + CW_ROWSS); (void)RS; unsigned long long* RSn = dummy ? nullptr : RS; (void)RSn;
#define PH_END   if (rep + 1 < NREP) xcd_barrier(bar, F0.wave); } if (ph + 1 < hi) xcd_barrier(bar, F0.wave); } ++ph;


    PH_BEGIN(0) p0_prologue(F); PH_END

    for (int layer = 0; layer < 2; ++layer) {
        if (layer == 0) {
            PH_BEGIN(1) if (QKV_NG < 256 && (int)blockIdx.x >= QKV_NG) {
                {
                    SchedX1 S{nullptr, nullptr, (const char*)(ws + WS_MEMN), (const char*)(ws + WS_WXKV), (int)blockIdx.x - QKV_NG, 2};
                    pg8::EpiX1 E{nullptr, (pg8::bf16_t*)(ws + WS_KV), (pg8::bf16_t*)(ws + WS_KV + 1 * MiB), nullptr};
                    pg8::gemm_phase<pg8::EpiX1, SchedX1, true>(F.lds, 8192u, 8192u, S, E, F.wave); }
                p0_convert(F, P0_FIRST_ITEMS, P0_NITEMS, ((int)blockIdx.x - QKV_NG) * NWAVES + F.wave, (256 - QKV_NG) * NWAVES); } else {
                pg8::SchedPlain S; S.A = xn; S.B = (const char*)(ws + WS_WQKV); S.lda = 8192; S.ldb = 8192; S.nt = 64; S.so.init(M, 3 * DM, QKV_NG < 256 ? QKV_NG : F.G, (int)blockIdx.x);
                pg8::EpiQKV E{(pg8::bf16_t*)(ws + WS_QKV), (size_t)M * DM, (const float*)(ws + WS_ROPE), (const float*)(ws + WS_ROPE) + (size_t)M * 16};
                pg8::gemm_phase<pg8::EpiQKV, pg8::SchedPlain, true>(F.lds, 8192u, 8192u, S, E, F.wave);
            } PH_END
            PH_BEGIN(2) {
                const bf16* Q = (const bf16*)(ws + WS_QKV); const bf16* K = Q + (size_t)M * DM; const bf16* V = K + (size_t)M * DM; bf16* On = (bf16*)(ws + WS_ON);
                static_assert(att::KS_BYTES <= RING_BYTES, "attention LDS");
                float lam;
                { const int l = F.lane; float s1 = arg_in(5)[l] * arg_in(6)[l] + arg_in(5)[l + 64] * arg_in(6)[l + 64], s2 = arg_in(7)[l] * arg_in(8)[l] + arg_in(7)[l + 64] * arg_in(8)[l + 64];
                  s1 = wave_sum(s1, l); s2 = wave_sum(s2, l); lam = expf(s1) - expf(s2) + LAM_INIT0; }
                const float* subg = arg_in(9);
                for (int i = 0; i < 4; ++i) {
                    const int x = F.vcu >> 5, qb = F.vcu & 31, bh = i * 8 + x, hh = bh & 15, b = bh >> 4;
                    const size_t hoff = (size_t)(b * 16 + hh) * 2 * SEQ * 128, qoff = hoff + (size_t)(qb * 128) * 128, ooff = (size_t)(b * SEQ + qb * 128) * DM + hh * 256;
                    unsigned o0p[4][8];
                    att::ATT_KS_BODY<128, 128, DM, 0, SEQ * 128 * 2>(Q + qoff, K + hoff, V + hoff, nullptr, SEQ, (char*)lds, F.wave, o0p, lam, subg, 1.f - LAM_INIT0);
                    att::ATT_KS_BODY<128, 128, DM, 1, SEQ * 128 * 2>(Q + qoff + (size_t)SEQ * 128, K + hoff + (size_t)SEQ * 128, V + hoff, On + ooff, SEQ, (char*)lds, F.wave, o0p, lam, subg, 1.f - LAM_INIT0);
                }
            } PH_END
            PH_BEGIN(4) {
                pg8::SchedPlain S; S.A = (const char*)(ws + WS_ON); S.B = (const char*)(ws + WS_WO); S.lda = 8192; S.ldb = 8192; S.nt = 64; S.so.init(M, DM, F.G, (int)blockIdx.x);
                pg8::EpiRes<DM, true> E{arg_in(0), h, RSn ? RSn + 0 * M : nullptr};
                pg8::gemm_phase<pg8::EpiRes<DM, true>, pg8::SchedPlain, true>(F.lds, 8192u, 8192u, S, E, F.wave);
            } PH_END
        } else {
            PH_BEGIN(6) {
                pg8::SchedPlain S; S.A = hA; S.B = (const char*)(ws + WS_WIN); S.lda = 8192; S.ldb = 8192; S.nt = 64; S.so.init(M, 2 * DM, F.G, (int)blockIdx.x);
                pg8::EpiBf16<0, 2 * DM> E{(pg8::bf16_t*)(ws + WS_QKV), RS + 2 * M};
                pg8::gemm_phase<pg8::EpiBf16<0, 2 * DM>, pg8::SchedPlain, true>(F.lds, 8192u, 8192u, S, E, F.wave);
            } PH_END
            PH_BEGIN(7) conv_phase(F); PH_END
            PH_BEGIN(8) {
                SchedGates S{(const char*)(ws + WS_ON), (const char*)(ws + WS_WG), F.vcu};
                pg8::EpiGates E; E.uc = (const pg8::bf16_t*)(ws + WS_ON); E.ba[0] = arg_in(16); E.ba[1] = arg_in(21); E.bi[0] = arg_in(18); E.bi[1] = arg_in(23);
                E.sp8[0] = (const float*)(ws + WS_SP8); E.sp8[1] = (const float*)(ws + WS_SP8) + DM; E.G = (unsigned*)(ws + WS_R256); E.aggA = (float*)(ws + WS_AGG); E.aggH = (float*)(ws + WS_AGG) + (size_t)2 * 2 * 64 * DM;
                pg8::gemm_phase<pg8::EpiGates, SchedGates, true>(F.lds, 8192u, 512u, S, E, F.wave);
            } PH_END
            PH_BEGIN(10) scan_carry_phase(F); PH_END
            PH_BEGIN(11) scan_final_phase(F); PH_END
            PH_BEGIN(12) {
                pg8::SchedPlain S; S.A = (const char*)(ws + WS_Y); S.B = (const char*)(ws + WS_WOUT); S.lda = 8192; S.ldb = 8192; S.nt = 64; S.so.init(M, DM, F.G, (int)blockIdx.x);
                pg8::EpiRes<DM, false> E{h, hout, RSn ? RSn + 3 * M : nullptr};
                pg8::gemm_phase<pg8::EpiRes<DM, false>, pg8::SchedPlain, true>(F.lds, 8192u, 8192u, S, E, F.wave);
            } PH_END
        }
        PH_BEGIN(14) {
            SchedX1 S{hA, (const char*)(ws + WS_WXQ + (size_t)layer * 4 * MiB), (const char*)(ws + WS_MEMN), (const char*)(ws + WS_WXKV), (int)blockIdx.x, 0};
            pg8::EpiX1 E{(float*)(ws + WS_SLAB), (pg8::bf16_t*)(ws + WS_KV), (pg8::bf16_t*)(ws + WS_KV + 1 * MiB), RS + (3 * layer) * M};
            pg8::gemm_phase<pg8::EpiX1, SchedX1, true>(F.lds, 8192u, 8192u, S, E, F.wave);
        } PH_END
        PH_BEGIN(15) {
            const int u = (int)blockIdx.x;
            if (u < 128) { const int b = u >> 6, hh = (u >> 4) & 3, qb = u & 15;
                const float* Qs = (const float*)(ws + WS_SLAB) + (size_t)(b * SEQ + qb * 256) * XW + hh * 128;
                const bf16* Kh = (const bf16*)(ws + WS_KV + (size_t)layer * MiB) + (size_t)(b * MEMT) * 1024 + hh * 128;
                bf16* Ob = (bf16*)(ws + WS_OX) + (size_t)(b * SEQ + qb * 256) * XW + hh * 128;
                int seqv = MEMT; asm volatile("" : "+s"(seqv));
                att::attn_dense_body<1, 1, XW, 1024, XW, ATT_SDEPTH>(Qs, (size_t)M * XW, Kh, Kh + XW, Ob, seqv, (char*)lds, F.wave); }
        } PH_END
        PH_BEGIN(16) {
            pg8::SchedPlain S; S.A = (const char*)(ws + WS_OX); S.B = (const char*)(ws + WS_WXO + (size_t)layer * 4 * MiB); S.lda = 1024; S.ldb = 1024; S.nt = 8; S.so.init(M, DM, F.G, (int)blockIdx.x);
            pg8::EpiRes<DM, false> E{h, hout, RSn ? RSn + (1 + 3 * layer) * M : nullptr};
            pg8::gemm_phase<pg8::EpiRes<DM, false>, pg8::SchedPlain, true>(F.lds, 1024u, 1024u, S, E, F.wave);
        } PH_END
        PH_BEGIN(18) {
            pg8::SchedPlain S; S.A = hA; S.B = (const char*)(ws + WS_W1 + (size_t)layer * 128 * MiB); S.lda = 8192; S.ldb = 8192; S.nt = 64; S.so.init(M, DFF, F.G, (int)blockIdx.x);
            pg8::EpiBf16<2, DFF> E{(pg8::bf16_t*)(ws + WS_R256), RS + (1 + 3 * layer) * M};
            pg8::gemm_phase<pg8::EpiBf16<2, DFF>, pg8::SchedPlain, true>(F.lds, 8192u, 8192u, S, E, F.wave);
        } PH_END
        PH_BEGIN(19) {
            pg8::SchedPlain S; S.A = (const char*)(ws + WS_R256); S.B = (const char*)(ws + WS_W2 + (size_t)layer * 128 * MiB); S.lda = 32768; S.ldb = 32768; S.nt = 256; S.so.init(M, DM, F.G, (int)blockIdx.x);
            pg8::EpiRes<DM, false> E{h, hout, (layer == 0 && RSn) ? RSn + 2 * M : nullptr};
            pg8::gemm_phase<pg8::EpiRes<DM, false>, pg8::SchedPlain, true>(F.lds, 32768u, 32768u, S, E, F.wave);
        } PH_END
    }
    PH_BEGIN(20) { const float* fg = arg_in(34); float* fo = arg_out(); for (int m = F.gw; m < M; m += F.NGW) rms_row_bf16_in((const bf16*)h + (size_t)m * DM, fg, fo + (size_t)m * DM, F.lane); } PH_END
#undef PH_BEGIN
#undef PH_END
}
constexpr int N_PHASES = 21;
#ifndef MK_CHECK
#define MK_CHECK 0
#endif
#ifndef MK_ONE_LAUNCH
#define MK_ONE_LAUNCH 1
#endif
#if MK_CHECK
constexpr int CHK_ROW0 = 3072, CHK_ROWS = 2048;
constexpr int CW_CHK = 65536;
__global__ __launch_bounds__(256) void k_cmp(const float* __restrict__ a, long lda, const void* __restrict__ b, long ldb, int b_bf16, float scale_b, int rows, int cols, float* acc) {
    __shared__ float red[4];
    float e = 0.f, r = 0.f;
    const long n = (long)rows * cols;
    for (long i = (long)blockIdx.x * 256 + threadIdx.x; i < n; i += (long)gridDim.x * 256) {
        const long row = i / cols, col = i % cols;
        const float av = a[row * lda + col];
        float bv = b_bf16 ? __uint_as_float((unsigned)((const unsigned short*)b)[row * ldb + col] << 16) : ((const float*)b)[row * ldb + col];
        bv *= scale_b; const float d = av - bv;
        if (!(d == d)) e += 1e30f; else e += d * d;
        r += av * av;
    }
    e = nv::block_sum_256(e, red); r = nv::block_sum_256(r, red);
    if (threadIdx.x == 0) { atomicAdd(acc, e); atomicAdd(acc + 1, r); }
}
__global__ void k_poison(const float* acc, int nchk, float tol, float* out) {
    if (threadIdx.x == 0 && blockIdx.x == 0) {
        for (int i = 0; i < nchk; ++i) { const float e = acc[2 * i], r = acc[2 * i + 1]; if (!(e <= tol * r)) { out[0] += 1000.f * (float)(i + 1); break; } }
    }
}
#endif

extern "C" void kernel_launch(void* const* d_in, const int* in_sizes, int n_in, void* d_out, int out_size, void* d_ws, size_t ws_size, hipStream_t stream) {
    static int grid = 0;
    if (grid == 0) {
        if (n_in != 35 || out_size != M * DM || ws_size < (size_t)2040 * MiB) { fprintf(stderr, "kernel_launch: unexpected shapes: n_in %d out %d ws %zu\n", n_in, out_size, ws_size); grid = -1; return; }
        int dev = 0, cus = 0, per_cu = 0;
        if (hipGetDevice(&dev) != hipSuccess || hipDeviceGetAttribute(&cus, hipDeviceAttributeMultiprocessorCount, dev) != hipSuccess) { grid = -1; return; }
        if (hipFuncSetAttribute((const void*)mega_fwd, hipFuncAttributeMaxDynamicSharedMemorySize, LDS_BYTES) != hipSuccess) { fprintf(stderr, "kernel_launch: hipFuncSetAttribute failed\n"); grid = -1; return; }
        if (hipOccupancyMaxActiveBlocksPerMultiprocessor(&per_cu, (const void*)mega_fwd, NWAVES * 64, LDS_BYTES) != hipSuccess || per_cu < 1) fprintf(stderr, "kernel_launch: occupancy query reports %d\n", per_cu);
        (void)hipGetLastError();
        grid = cus;
#if MK_CHECK
        (void)hipFuncSetAttribute((const void*)nv::k_diffattn, hipFuncAttributeMaxDynamicSharedMemorySize, nv::AT_SM_FLOATS * 4);
#endif
    }
    if (grid < 0) return;
    (void)hipMemsetAsync((char*)d_ws + WS_CTL, 0, CTL_ZERO_BYTES, stream);
    Args a{};
    for (int i = 0; i < 35; ++i) a.in[i] = (const float*)d_in[i];
    a.out = (float*)d_out; a.ws = (unsigned char*)d_ws;
#if !MK_CHECK
#if MK_ONE_LAUNCH
    a.ph_lo = 0; a.ph_hi = N_PHASES;
    hipLaunchKernelGGL(mega_fwd, dim3(grid), dim3(NWAVES * 64), LDS_BYTES, stream, a);
#else
    for (int p = 0; p < N_PHASES; ++p) { a.ph_lo = p; a.ph_hi = p + 1; hipLaunchKernelGGL(mega_fwd, dim3(grid), dim3(NWAVES * 64), LDS_BYTES, stream, a); }
#endif
#else
    char* ws = (char*)d_ws;
    char* stash = ws + (size_t)1720 * MiB; size_t so = 0;
    auto stash_rows = [&](size_t src_off, size_t row_bytes) { char* p = stash + so; (void)hipMemcpyAsync(p, ws + src_off + (size_t)CHK_ROW0 * row_bytes, (size_t)CHK_ROWS * row_bytes, hipMemcpyDeviceToDevice, stream); so += (size_t)CHK_ROWS * row_bytes; return p; };
    char *sQ = nullptr, *sK = nullptr, *sV = nullptr, *sOn = nullptr, *sH4 = nullptr, *sH8 = nullptr, *sH11 = nullptr, *sUc = nullptr, *sY = nullptr, *sH19 = nullptr, *sH23 = nullptr, *sOut = nullptr;
    for (int p = 0; p < N_PHASES; ++p) {
        a.ph_lo = p; a.ph_hi = p + 1; hipLaunchKernelGGL(mega_fwd, dim3(grid), dim3(NWAVES * 64), LDS_BYTES, stream, a);
        if (p == 1) { sQ = stash_rows(WS_QKV, DM * 2); sK = stash_rows(WS_QKV + 64 * MiB, DM * 2); sV = stash_rows(WS_QKV + 128 * MiB, DM * 2); }
        if (p == 2) sOn = stash_rows(WS_ON, DM * 2);
        if (p == 3) sH4 = stash_rows(WS_H, DM * 2);
        if (p == 6) sH8 = stash_rows(WS_H, DM * 2);
        if (p == 8) sH11 = stash_rows(WS_H, DM * 2);
        if (p == 10) sUc = stash_rows(WS_ON, DM * 2);
        if (p == 14) sY = stash_rows(WS_Y, DM * 2);
        if (p == 15) sH19 = stash_rows(WS_H, DM * 2);
        if (p == 18) sH23 = stash_rows(WS_H, DM * 2);
        if (p == 21) { sOut = stash + so; (void)hipMemcpyAsync(sOut, (char*)d_out + (size_t)CHK_ROW0 * DM * 4, (size_t)CHK_ROWS * DM * 4, hipMemcpyDeviceToDevice, stream); so += (size_t)CHK_ROWS * DM * 4; }
    }
    {
        using namespace nv;
        const size_t Fz = sizeof(float); const size_t SZ_H = (size_t)M * DM * Fz, SZ_BIG = (size_t)M * DFF * Fz;
        size_t off = 1 * MiB;
        auto carve = [&](size_t bytes) { float* p = (float*)(ws + off); off += (bytes + 255) / 256 * 256; return p; };
        float* h = carve(SZ_H); float* xn = carve(SZ_H); float* big = carve(SZ_BIG);
        float* t1 = carve(SZ_H); float* t2 = carve(SZ_H); float* t3 = carve(SZ_H); float* t4 = carve(SZ_H); float* t5 = carve(SZ_H);
        float* memn = carve((size_t)NB * MEMT * DM * Fz); float* kvb = carve((size_t)NB * MEMT * 2 * XW * Fz); float* qx = carve((size_t)M * XW * Fz); float* ox = carve((size_t)M * XW * Fz);
        float* lamd = carve(256);
        if (off > (size_t)1720 * MiB) { fprintf(stderr, "check build: naive buffers overflow\n"); return; }
        float* acc = (float*)ws + CW_CHK; int ci = 0;
        auto cmp = [&](const float* nav, long lda, const char* st, long ldb, int isbf, float sc, int cols) {
            hipLaunchKernelGGL(k_cmp, dim3(1024), dim3(256), 0, stream, nav + (size_t)CHK_ROW0 * lda, lda, (const void*)st, ldb, isbf, sc, CHK_ROWS, cols, acc + 2 * ci); ++ci; };
        auto in = [&](int i) { return (const float*)d_in[i]; };
        auto gemm = [&](const float* A, int lda, const float* B, int ldb, float* C, int ldc, int m, int n, int k, int accum, int batch = 1, long sA = 0, long sB = 0, long sC = 0) {
            hipLaunchKernelGGL(k_gemm, dim3(n / 128, m / 128, batch), dim3(256), 0, stream, A, lda, sA, B, ldb, sB, C, ldc, sC, k, accum); };
        const float* x = in(0); const float* mem = in(1); const int* pos = (const int*)d_in[2];
        (void)hipMemcpyAsync(h, x, SZ_H, hipMemcpyDeviceToDevice, stream);
        for (int layer = 0; layer < 2; ++layer) {
            if (layer == 0) {
                hipLaunchKernelGGL(k_rmsnorm, dim3(M), dim3(256), 0, stream, h, in(3), xn, DM, 1.f);
                gemm(xn, DM, in(4), 3 * DM, big, 3 * DM, M, 3 * DM, DM, 0);
                hipLaunchKernelGGL(k_rope, dim3(M), dim3(256), 0, stream, big, pos);
                cmp(big, 3 * DM, sQ, DM, 1, 0.08838834764831845f, DM);
                cmp(big + DM, 3 * DM, sK, DM, 1, 1.f, DM);
                cmp(big + 2 * DM, 3 * DM, sV, DM, 1, 1.f, DM);
                hipLaunchKernelGGL(k_lambda, dim3(1), dim3(64), 0, stream, in(5), in(6), in(7), in(8), 0.2f, lamd);
                hipLaunchKernelGGL(k_diffattn, dim3(SEQ / AT_Q, NH, NB), dim3(256), AT_SM_FLOATS * 4, stream, big, lamd, t1);
                hipLaunchKernelGGL(k_rmsnorm, dim3(M * NH), dim3(256), 0, stream, t1, in(9), t2, VD, 0.8f);
                cmp(t2, DM, sOn, DM, 1, 1.f, DM);
                gemm(t2, DM, in(10), DM, h, DM, M, DM, DM, 1);
                cmp(h, DM, sH4, DM, 1, 1.f, DM);
            } else {
                hipLaunchKernelGGL(k_rmsnorm, dim3(M), dim3(256), 0, stream, h, in(11), xn, DM, 1.f);
                gemm(xn, DM, in(12), 2 * DM, big, 2 * DM, M, 2 * DM, DM, 0);
                hipLaunchKernelGGL(k_conv, dim3(M * DM / 256), dim3(256), 0, stream, big, in(13), in(14), t1);
                cmp(t1, DM, sUc, DM, 1, 1.f, DM);
                gemm(t1, DM, in(15), 256, t2, DM, M, 256, 256, 0, 16, 256, 65536, 256);
                gemm(t1, DM, in(17), 256, t3, DM, M, 256, 256, 0, 16, 256, 65536, 256);
                hipLaunchKernelGGL(k_scan, dim3(NB * DM / 64), dim3(64), 0, stream, t2, t3, t1, in(16), in(18), in(19), t4, 0);
                gemm(t1, DM, in(20), 256, t2, DM, M, 256, 256, 0, 16, 256, 65536, 256);
                gemm(t1, DM, in(22), 256, t3, DM, M, 256, 256, 0, 16, 256, 65536, 256);
                hipLaunchKernelGGL(k_scan, dim3(NB * DM / 64), dim3(64), 0, stream, t2, t3, t1, in(21), in(23), in(24), t4, 1);
                hipLaunchKernelGGL(k_gate, dim3(M * DM / 256), dim3(256), 0, stream, t4, big, t5);
                cmp(t5, DM, sY, DM, 1, 1.f, DM);
                gemm(t5, DM, in(25), DM, h, DM, M, DM, DM, 1);
                cmp(h, DM, sH19, DM, 1, 1.f, DM);
            }
            hipLaunchKernelGGL(k_rmsnorm, dim3(M), dim3(256), 0, stream, h, in(26) + layer * DM, xn, DM, 1.f);
            gemm(xn, DM, in(28) + (size_t)layer * DM * XW, XW, qx, XW, M, XW, DM, 0);
            hipLaunchKernelGGL(k_rmsnorm, dim3(NB * MEMT), dim3(256), 0, stream, mem, in(27) + layer * DM, memn, DM, 1.f);
            gemm(memn, DM, in(29) + (size_t)layer * DM * 2 * XW, 2 * XW, kvb, 2 * XW, NB * MEMT, 2 * XW, DM, 0);
            hipLaunchKernelGGL(k_xattn, dim3(M, XH), dim3(64), 0, stream, qx, kvb, ox);
            gemm(ox, XW, in(30) + (size_t)layer * XW * DM, DM, h, DM, M, DM, XW, 1);
            cmp(h, DM, layer == 0 ? sH8 : sH23, DM, 1, 1.f, DM);
            hipLaunchKernelGGL(k_rmsnorm, dim3(M), dim3(256), 0, stream, h, in(31) + layer * DM, xn, DM, 1.f);
            gemm(xn, DM, in(32) + (size_t)layer * DM * DFF, DFF, big, DFF, M, DFF, DM, 0);
            hipLaunchKernelGGL(k_relu2, dim3((size_t)M * DFF / 256), dim3(256), 0, stream, big);
            gemm(big, DFF, in(33) + (size_t)layer * DFF * DM, DM, h, DM, M, DM, DFF, 1);
            if (layer == 0) cmp(h, DM, sH11, DM, 1, 1.f, DM);
        }
        hipLaunchKernelGGL(k_rmsnorm, dim3(M), dim3(256), 0, stream, h, in(34), (float*)d_out, DM, 1.f);
        cmp((float*)d_out, DM, sOut, DM, 0, 1.f, DM);
        hipLaunchKernelGGL(k_poison, dim3(1), dim3(64), 0, stream, acc, ci, 2e-3f, (float*)d_out);
    }
#endif
}
```
